# Optimizing an MI355X kernel written in HIP

```python
import jax, jax.numpy as jnp
from jax import lax
import numpy as np

D_MODEL = 1024
BATCH = 16
SEQ = 256
DEPTH = 4
DEC_BATCH = 8
DEC_SEQ = 2048
PAST_LEN = 256

GRID_W = 64
N_AB_LAYERS = (DEPTH + 1) // 2
N_F_LAYERS = DEPTH // 2
A_HEADS = 8
A_KV_HEADS = 2
A_GROUP = A_HEADS // A_KV_HEADS
A_HEAD_DIM = 64
WINDOW = 128
BAND = 128
B_HEADS = 8
B_NOPE_DIM = 64
B_ROPE_DIM = 32
B_V_DIM = 64
B_Q_LORA = 384
B_KV_LORA = 256
A_Q_W = A_HEADS * A_HEAD_DIM
A_KV_W = A_KV_HEADS * A_HEAD_DIM
AB_SPLITS = (A_Q_W, A_Q_W + A_KV_W, A_Q_W + 2 * A_KV_W, A_Q_W + 2 * A_KV_W + B_Q_LORA,
             A_Q_W + 2 * A_KV_W + B_Q_LORA + B_KV_LORA)
AB_IN = AB_SPLITS[-1] + B_ROPE_DIM
AB_MIX = A_HEADS * A_HEAD_DIM + B_HEADS * B_V_DIM
A_SCALE = A_HEAD_DIM ** -0.5
B_SCALE = (B_NOPE_DIM + B_ROPE_DIM) ** -0.5
F_GROUPS = 4
F_WIDTH = D_MODEL
F_GROUP_DIM = F_WIDTH // F_GROUPS
D_FF = 2816
FFN_HALF = 0.5
ALPHA = (2 * DEPTH) ** 0.25
BETA = (8 * DEPTH) ** -0.25
LN_EPS = 1e-5
RMS_EPS = 1e-6
N_MODS = 9
Q_BLOCK = 128
ROPE_BASE = 10000.0
NEG_INF = -1e30

kernel_name = "hybrid_dit_swa_mla_fnet_macaron_step"


def layer_norm(x, g, b):
    xf = x.astype(jnp.float32)
    xc = xf - jnp.mean(xf, axis=-1, keepdims=True)
    var = jnp.mean(xc * xc, axis=-1, keepdims=True)
    return (xc * lax.rsqrt(var + LN_EPS) * g.astype(jnp.float32) + b.astype(jnp.float32)).astype(x.dtype)


def rms_norm(x, g):
    xf = x.astype(jnp.float32)
    y = xf * lax.rsqrt(jnp.mean(xf * xf, axis=-1, keepdims=True) + RMS_EPS)
    return (y * g.astype(jnp.float32)).astype(x.dtype)


def ada_mods(cond, w, b):
    return jnp.split(jax.nn.silu(cond) @ w + b, N_MODS, axis=-1)


def modulate(x, shift, scale):
    return x * (1.0 + scale[:, None, :]) + shift[:, None, :]


def post_norm(x, out, gate, g, b):
    return layer_norm(ALPHA * x + gate[:, None, :] * out, g, b)


def swiglu(h, w_gate, w_up, w_down):
    return (jax.nn.silu(h @ w_gate) * (h @ w_up)) @ w_down


def half_ffn(x, shift, scale, gate, w_gate, w_up, w_down, g, b):
    h = modulate(x, shift, scale)
    return post_norm(x, FFN_HALF * swiglu(h, w_gate, w_up, w_down), gate, g, b)


def rope_1d(x, pos):
    half = x.shape[-1] // 2
    inv = ROPE_BASE ** (-jnp.arange(half, dtype=jnp.float32) / half)
    ang = pos.astype(jnp.float32)[:, None] * inv[None, :]
    ang = ang.reshape((ang.shape[0],) + (1,) * (x.ndim - 3) + (half,))
    cos = jnp.cos(ang).astype(x.dtype)
    sin = jnp.sin(ang).astype(x.dtype)
    x1, x2 = x[..., :half], x[..., half:]
    return jnp.concatenate([x1 * cos - x2 * sin, x2 * cos + x1 * sin], axis=-1)


def axial_rope(x):
    L = x.shape[1]
    rows = L // GRID_W
    row = jnp.repeat(jnp.arange(rows), GRID_W)
    col = jnp.tile(jnp.arange(GRID_W), rows)
    h = x.shape[-1] // 2
    return jnp.concatenate([rope_1d(x[..., :h], row), rope_1d(x[..., h:], col)], axis=-1)


def sink_softmax(s, sink):
    m = jnp.maximum(jnp.max(s, axis=-1, keepdims=True), sink)
    p = jnp.exp(s - m)
    return p / (jnp.sum(p, axis=-1, keepdims=True) + jnp.exp(sink - m))


def dense_attention(q, k, v, scale, sink):
    bsz, lq, hk, g, dk = q.shape
    qb = q.reshape(bsz, lq // Q_BLOCK, Q_BLOCK, hk, g, dk).swapaxes(0, 1)

    def block(qi):
        s = jnp.einsum("bqhgd,bkhd->bhgqk", qi, k).astype(jnp.float32) * scale
        if sink is None:
            p = jax.nn.softmax(s, axis=-1)
        else:
            p = sink_softmax(s, sink.astype(jnp.float32)[None, :, :, None, None])
        return jnp.einsum("bhgqk,bkhd->bqhgd", p.astype(v.dtype), v)

    o = lax.map(block, qb)
    return o.swapaxes(0, 1).reshape(bsz, lq, hk, g, v.shape[-1])


def banded_attention(q, k, v, kc, vc, scale, sink):
    bsz, L, hk, g, dk = q.shape
    nb = L // BAND
    pad = ((0, 0), (BAND, BAND), (0, 0), (0, 0))
    kp = jnp.pad(k, pad).reshape(bsz, nb + 2, BAND, hk, dk)
    vp = jnp.pad(v, pad).reshape(bsz, nb + 2, BAND, hk, v.shape[-1])
    kw = jnp.concatenate([kp[:, :-2], kp[:, 1:-1], kp[:, 2:]], axis=2)
    vw = jnp.concatenate([vp[:, :-2], vp[:, 1:-1], vp[:, 2:]], axis=2)
    qb = q.reshape(bsz, nb, BAND, hk, g, dk)
    s_loc = jnp.einsum("bnqhgd,bnkhd->bhgnqk", qb, kw).astype(jnp.float32) * scale
    qpos = jnp.arange(nb)[:, None] * BAND + jnp.arange(BAND)[None, :]
    kpos = (jnp.arange(nb)[:, None] * BAND - BAND + jnp.arange(3 * BAND)[None, :])[:, None, :]
    valid = (kpos >= 0) & (kpos < L) & (jnp.abs(kpos - qpos[:, :, None]) <= WINDOW)
    s_loc = jnp.where(valid, s_loc, NEG_INF)
    s_ctx = jnp.einsum("bnqhgd,bchd->bhgnqc", qb, kc).astype(jnp.float32) * scale
    lc = kc.shape[1]
    p = sink_softmax(jnp.concatenate([s_ctx, s_loc], axis=-1),
                     sink.astype(jnp.float32)[None, :, :, None, None, None]).astype(v.dtype)
    o = (jnp.einsum("bhgnqc,bchd->bnqhgd", p[..., :lc], vc)
         + jnp.einsum("bhgnqk,bnkhd->bnqhgd", p[..., lc:], vw))
    return o.reshape(bsz, L, hk, g, v.shape[-1])


def split_ab(proj):
    bsz, L, _ = proj.shape
    qa, ka, va, cq, ckv, kpe = jnp.split(proj, AB_SPLITS, axis=-1)
    qa = qa.reshape(bsz, L, A_KV_HEADS, A_GROUP, A_HEAD_DIM)
    ka = ka.reshape(bsz, L, A_KV_HEADS, A_HEAD_DIM)
    va = va.reshape(bsz, L, A_KV_HEADS, A_HEAD_DIM)
    return qa, ka, va, cq, ckv, kpe


def mla_q(cq, g_cq, w_uq):
    bsz, L, _ = cq.shape
    return (rms_norm(cq, g_cq) @ w_uq).reshape(bsz, L, B_HEADS, B_NOPE_DIM + B_ROPE_DIM)


def mla_kv(ckv_n, w_ukv):
    bsz, L, _ = ckv_n.shape
    kv = (ckv_n @ w_ukv).reshape(bsz, L, B_HEADS, B_NOPE_DIM + B_V_DIM)
    return kv[..., :B_NOPE_DIM], kv[..., B_NOPE_DIM:]


def mla_keys(k_nope, kpe):
    kpe_h = jnp.broadcast_to(kpe[:, :, None, :], k_nope.shape[:3] + (B_ROPE_DIM,))
    return jnp.concatenate([k_nope, kpe_h], axis=-1)


def merge_heads(o_a, o_b, w_out):
    bsz, L = o_a.shape[:2]
    return jnp.concatenate([o_a.reshape(bsz, L, -1), o_b.reshape(bsz, L, -1)], axis=-1) @ w_out


def ab_mixer_context(h, w_in, w_out, sink, g_cq, w_uq, g_ckv, w_ukv):
    qa, ka, va, cq, ckv, kpe = split_ab(h @ w_in)
    ckv_n = rms_norm(ckv, g_ckv)
    qb = mla_q(cq, g_cq, w_uq)
    k_nope, vb = mla_kv(ckv_n, w_ukv)
    o_a = dense_attention(qa, ka, va, A_SCALE, sink.reshape(A_KV_HEADS, A_GROUP))
    o_b = dense_attention(qb[:, :, :, None, :], mla_keys(k_nope, kpe), vb, B_SCALE, None)
    return merge_heads(o_a, o_b, w_out), ka, va, ckv_n, kpe


def ab_mixer_latent(h, ck_a, cv_a, c_ckv, c_kpe, w_in, w_out, sink, g_cq, w_uq, g_ckv, w_ukv):
    qa, ka, va, cq, ckv, kpe = split_ab(h @ w_in)
    o_a = banded_attention(axial_rope(qa), axial_rope(ka), va, ck_a, cv_a, A_SCALE,
                           sink.reshape(A_KV_HEADS, A_GROUP))
    qb = mla_q(cq, g_cq, w_uq)
    qb = jnp.concatenate([qb[..., :B_NOPE_DIM], axial_rope(qb[..., B_NOPE_DIM:])], axis=-1)
    k_nope, vb = mla_kv(rms_norm(ckv, g_ckv), w_ukv)
    kc_nope, vc = mla_kv(c_ckv, w_ukv)
    k_all = jnp.concatenate([mla_keys(kc_nope, c_kpe), mla_keys(k_nope, axial_rope(kpe))], axis=1)
    v_all = jnp.concatenate([vc, vb], axis=1)
    o_b = dense_attention(qb[:, :, :, None, :], k_all, v_all, B_SCALE, None)
    return merge_heads(o_a, o_b, w_out)


def fourier_mixer(h, w_in, w_out):
    bsz, L, _ = h.shape
    u = (h @ w_in).reshape(bsz, L, F_GROUPS, F_GROUP_DIM).astype(jnp.float32)
    f = jnp.fft.fft2(u, axes=(1, 3), norm="ortho").real
    return f.astype(h.dtype).reshape(bsz, L, F_WIDTH) @ w_out


def setup_inputs(seed: int = 0) -> dict:
    key = jax.random.key(seed)
    ks = jax.random.split(key, 26)

    def nrm(k, shape, s):
        return s * jax.random.normal(k, shape, jnp.float32)

    return {
        "x_prompt": nrm(ks[0], (BATCH, SEQ, D_MODEL), 1.0),
        "x_sample": nrm(ks[1], (DEC_BATCH, DEC_SEQ, D_MODEL), 1.0),
        "cache_a_k": nrm(ks[2], (DEC_BATCH, N_AB_LAYERS, PAST_LEN, A_KV_HEADS, A_HEAD_DIM), 1.0),
        "cache_a_v": nrm(ks[3], (DEC_BATCH, N_AB_LAYERS, PAST_LEN, A_KV_HEADS, A_HEAD_DIM), 1.0),
        "cache_b_ckv": nrm(ks[4], (DEC_BATCH, N_AB_LAYERS, PAST_LEN, B_KV_LORA), 1.0),
        "cache_b_kpe": nrm(ks[5], (DEC_BATCH, N_AB_LAYERS, PAST_LEN, B_ROPE_DIM), 1.0),
        "c": nrm(ks[6], (DEC_BATCH, D_MODEL), 1.0),
        "c_ctx": nrm(ks[7], (D_MODEL,), 1.0),
        "w_ada": nrm(ks[8], (DEPTH, D_MODEL, N_MODS * D_MODEL), 0.5 * D_MODEL ** -0.5),
        "b_ada": nrm(ks[9], (DEPTH, N_MODS * D_MODEL), 0.02),
        "ln_g": 1.0 + nrm(ks[10], (DEPTH, 3, D_MODEL), 0.02),
        "ln_b": nrm(ks[11], (DEPTH, 3, D_MODEL), 0.02),
        "ffn_w_gate": nrm(ks[12], (DEPTH, 2, D_MODEL, D_FF), D_MODEL ** -0.5),
        "ffn_w_up": nrm(ks[13], (DEPTH, 2, D_MODEL, D_FF), D_MODEL ** -0.5),
        "ffn_w_down": nrm(ks[14], (DEPTH, 2, D_FF, D_MODEL), BETA * D_FF ** -0.5),
        "ab_w_in": nrm(ks[15], (N_AB_LAYERS, D_MODEL, AB_IN), D_MODEL ** -0.5),
        "ab_w_out": nrm(ks[16], (N_AB_LAYERS, AB_MIX, D_MODEL), BETA * AB_MIX ** -0.5),
        "a_sink": nrm(ks[17], (N_AB_LAYERS, A_HEADS), 0.5),
        "b_g_cq": 1.0 + nrm(ks[18], (N_AB_LAYERS, B_Q_LORA), 0.02),
        "b_w_uq": nrm(ks[19], (N_AB_LAYERS, B_Q_LORA, B_HEADS * (B_NOPE_DIM + B_ROPE_DIM)), B_Q_LORA ** -0.5),
        "b_g_ckv": 1.0 + nrm(ks[20], (N_AB_LAYERS, B_KV_LORA), 0.02),
        "b_w_ukv": nrm(ks[21], (N_AB_LAYERS, B_KV_LORA, B_HEADS * (B_NOPE_DIM + B_V_DIM)), B_KV_LORA ** -0.5),
        "f_w_in": nrm(ks[22], (N_F_LAYERS, D_MODEL, F_WIDTH), D_MODEL ** -0.5),
        "f_w_out": nrm(ks[23], (N_F_LAYERS, F_WIDTH, D_MODEL), BETA * F_WIDTH ** -0.5),
    }


def reference(x_prompt, x_sample, cache_a_k, cache_a_v, cache_b_ckv, cache_b_kpe, c, c_ctx,
              w_ada, b_ada, ln_g, ln_b, ffn_w_gate, ffn_w_up, ffn_w_down, ab_w_in, ab_w_out,
              a_sink, b_g_cq, b_w_uq, b_g_ckv, b_w_ukv, f_w_in, f_w_out):
    y_p = x_prompt
    y_s = x_sample
    new_k, new_v, new_ckv, new_kpe = [], [], [], []
    for l in range(DEPTH):
        mc = ada_mods(c_ctx[None, :], w_ada[l], b_ada[l])
        ms = ada_mods(c, w_ada[l], b_ada[l])
        ffn_pre = (ffn_w_gate[l, 0], ffn_w_up[l, 0], ffn_w_down[l, 0], ln_g[l, 0], ln_b[l, 0])
        y_p = half_ffn(y_p, mc[0], mc[1], mc[2], *ffn_pre)
        y_s = half_ffn(y_s, ms[0], ms[1], ms[2], *ffn_pre)
        h_p = modulate(y_p, mc[3], mc[4])
        h_s = modulate(y_s, ms[3], ms[4])
        i = l // 2
        if l % 2 == 0:
            mla_w = (b_g_cq[i], b_w_uq[i], b_g_ckv[i], b_w_ukv[i])
            o_p, ka, va, ckv_n, kpe = ab_mixer_context(h_p, ab_w_in[i], ab_w_out[i], a_sink[i], *mla_w)
            o_s = ab_mixer_latent(h_s, cache_a_k[:, i], cache_a_v[:, i], cache_b_ckv[:, i], cache_b_kpe[:, i],
                                  ab_w_in[i], ab_w_out[i], a_sink[i], *mla_w)
            new_k.append(ka)
            new_v.append(va)
            new_ckv.append(ckv_n)
            new_kpe.append(kpe)
        else:
            o_p = fourier_mixer(h_p, f_w_in[i], f_w_out[i])
            o_s = fourier_mixer(h_s, f_w_in[i], f_w_out[i])
        y_p = post_norm(y_p, o_p, mc[5], ln_g[l, 1], ln_b[l, 1])
        y_s = post_norm(y_s, o_s, ms[5], ln_g[l, 1], ln_b[l, 1])
        ffn_post = (ffn_w_gate[l, 1], ffn_w_up[l, 1], ffn_w_down[l, 1], ln_g[l, 2], ln_b[l, 2])
        y_p = half_ffn(y_p, mc[6], mc[7], mc[8], *ffn_post)
        y_s = half_ffn(y_s, ms[6], ms[7], ms[8], *ffn_post)
    y_prompt = y_p
    y_sample = y_s
    new_a_k = jnp.stack(new_k, axis=1)
    new_a_v = jnp.stack(new_v, axis=1)
    new_b_ckv = jnp.stack(new_ckv, axis=1)
    new_b_kpe = jnp.stack(new_kpe, axis=1)
    return (y_prompt, y_sample, new_a_k, new_a_v, new_b_ckv, new_b_kpe)
```

```cpp
#include <hip/hip_runtime.h>
#include <hip/hip_cooperative_groups.h>
#include <cstdio>
#include <cstdint>
#include <cstring>
namespace cg = cooperative_groups;


#ifndef SINGLE_LAUNCH
#define SINGLE_LAUNCH 1
#endif

#define LAS __attribute__((address_space(3)))
typedef unsigned short bf16_t;
typedef short bf16x8 __attribute__((ext_vector_type(8)));
typedef float f32x4 __attribute__((ext_vector_type(4)));
typedef unsigned u32x4 __attribute__((ext_vector_type(4)));
typedef unsigned u32x2 __attribute__((ext_vector_type(2)));
typedef _Float16 f16x4_t __attribute__((ext_vector_type(4)));

constexpr int D = 1024, FF = 2816, TC = 4096, TL = 16384, T = TC + TL, KR = TC + 8 * 2304;
constexpr int NPH = 47;
constexpr float ALPHA = 1.6817928305074290f;
constexpr float LOG2E = 1.4426950408889634f;
constexpr float QA_SCALE = 0.125f * LOG2E;
constexpr float QB_SCALE = 0.10206207261596575f * LOG2E;
constexpr float INV2PI = 0.15915494309189535f;
constexpr float LOG2_10000 = 13.287712379549449f;

constexpr size_t al256(size_t x) { return (x + 255) & ~(size_t)255; }
constexpr size_t OFF_W1T = 0;
constexpr size_t OFF_W2T = OFF_W1T + (size_t)8 * 5632 * 1024 * 2;
constexpr size_t OFF_WINT = OFF_W2T + (size_t)8 * 1024 * 2816 * 2;
constexpr size_t OFF_WOUTT = OFF_WINT + (size_t)2 * 1536 * 1024 * 2;
constexpr size_t OFF_WUQT = OFF_WOUTT + (size_t)2 * 1024 * 1024 * 2;
constexpr size_t OFF_WUKT = OFF_WUQT + (size_t)2 * 768 * 384 * 2;
constexpr size_t OFF_WUVT = OFF_WUKT + (size_t)2 * 512 * 256 * 2;
constexpr size_t OFF_WFING = OFF_WUVT + (size_t)2 * 512 * 256 * 2;
constexpr size_t OFF_CST = OFF_WFING + (size_t)2 * 4 * 1024 * 256 * 2;
constexpr size_t OFF_WFOLD = OFF_CST + (size_t)512 * 256 * 2;
constexpr size_t OFF_WFOUTT = OFF_WFOLD + (size_t)2 * 2048 * 1024 * 2;
constexpr size_t OFF_TWLAT = OFF_WFOUTT + (size_t)2 * 1024 * 1024 * 2;
constexpr size_t OFF_TWCTX = OFF_TWLAT + (size_t)2048 * 4096 * 2;
constexpr size_t OFF_MODS = OFF_TWCTX + (size_t)256 * 512 * 2;
constexpr size_t OFF_HMOD = OFF_MODS + (size_t)4 * 9 * 9216 * 4;
constexpr size_t OFF_Z = OFF_HMOD + (size_t)T * 1024 * 2;
constexpr size_t OFF_SCR = OFF_Z + (size_t)T * 1024 * 4;
constexpr size_t SCR_HFF = 0;
constexpr size_t SCR_MODP = 0;
constexpr size_t SCR_PROJ = 0;
constexpr size_t SCR_QB = 0;
constexpr size_t SCR_KN = SCR_QB + (size_t)T * 768 * 2;
constexpr size_t SCR_VT = SCR_KN + (size_t)KR * 512 * 2;
constexpr size_t SCR_AO = SCR_VT + (size_t)512 * KR * 2;
constexpr size_t SCR_PROJ_END = (size_t)T * 1536 * 4;
static_assert(SCR_AO + (size_t)T * 1024 * 2 <= SCR_PROJ_END, "alias overflow");
constexpr size_t SCR_QA = SCR_PROJ_END;
constexpr size_t SCR_KA = SCR_QA + (size_t)T * 512 * 2;
constexpr size_t SCR_VAT = SCR_KA + (size_t)KR * 128 * 2;
constexpr size_t SCR_CQN = SCR_VAT + (size_t)128 * KR * 2;
constexpr size_t SCR_CKVN = SCR_CQN + (size_t)T * 384 * 2;
constexpr size_t SCR_KPE = SCR_CKVN + (size_t)KR * 256 * 2;
constexpr size_t SCR_EVEN_END = SCR_KPE + (size_t)KR * 32 * 2;
constexpr size_t SCR_PTL = 0;
constexpr size_t SCR_PTC = SCR_PTL + (size_t)8 * 1024 * 4096 * 2;
constexpr size_t SCR_FM = SCR_PTC + (size_t)16 * 1024 * 512 * 2;
static_assert(SCR_FM + (size_t)T * 1024 * 2 <= SCR_EVEN_END, "odd alias overflow");
static_assert((size_t)T * 2816 * 2 <= SCR_EVEN_END, "hff alias overflow");
constexpr size_t SCR_Z1 = SCR_PROJ_END;
constexpr size_t OFF_BAR = OFF_SCR + SCR_Z1 + (size_t)T * 1024 * 4;
constexpr size_t WS_NEED = OFF_BAR + 16384;
constexpr size_t O_AK = (size_t)T * 1024, O_AV = O_AK + 16 * 2 * 256 * 128, O_CKV = O_AV + 16 * 2 * 256 * 128, O_KPE = O_CKV + 16 * 2 * 256 * 256;

constexpr int LDS_BYTES = 131072 + 16;

struct TJob { const float* src; bf16_t* dst; int K, lds, ncols, nvalid, sblk, sstride, soff, dblk, dstride, doff, tile0, pad; };
constexpr int NJOBS = 36;

struct Params {
    const float *x_prompt, *x_sample, *cache_a_k, *cache_a_v, *cache_b_ckv, *cache_b_kpe, *c, *c_ctx, *w_ada, *b_ada, *ln_g, *ln_b,
        *ffn_w_gate, *ffn_w_up, *ffn_w_down, *ab_w_in, *ab_w_out, *a_sink, *b_g_cq, *b_w_uq, *b_g_ckv, *b_w_ukv, *f_w_in, *f_w_out;
    float* out; unsigned char* ws;
    int ph_lo, ph_hi, ntiles_total, pad;
    TJob jobs[NJOBS];
};

typedef const __attribute__((address_space(4))) Params* KP;
__device__ __forceinline__ int ltid() { int t = threadIdx.x; asm volatile("" : "+v"(t)); return t; }
typedef __bf16 bf16v2_t __attribute__((ext_vector_type(2)));
typedef float f32v2_t __attribute__((ext_vector_type(2)));
__device__ __forceinline__ unsigned cvt_pk_bf16(float lo, float hi) { const f32v2_t v = {lo, hi}; const bf16v2_t b = __builtin_convertvector(v, bf16v2_t); return __builtin_bit_cast(unsigned, b); }
__device__ __forceinline__ bf16_t f2bf(float f) { return (bf16_t)(cvt_pk_bf16(f, 0.f) & 0xffffu); }
typedef unsigned u32pair __attribute__((ext_vector_type(2)));
template <int CTRL> __device__ __forceinline__ float dpp_f(float v) { return __builtin_bit_cast(float, __builtin_amdgcn_update_dpp(0, __builtin_bit_cast(int, v), CTRL, 0xf, 0xf, true)); }
#define SWAP_COMBINE(name_, insn_, expr_) __device__ __forceinline__ float name_(float v) { unsigned a = __builtin_bit_cast(unsigned, v); unsigned b = a; \
    asm volatile("s_nop 1\n\t" insn_ " %0, %1\n\ts_nop 1" : "+v"(a), "+v"(b)); const float x = __builtin_bit_cast(float, a), y = __builtin_bit_cast(float, b); return expr_; }
SWAP_COMBINE(xor16_sum, "v_permlane16_swap_b32", x + y)
SWAP_COMBINE(xor32_sum, "v_permlane32_swap_b32", x + y)
SWAP_COMBINE(xor16_max, "v_permlane16_swap_b32", fmaxf(x, y))
SWAP_COMBINE(xor32_max, "v_permlane32_swap_b32", fmaxf(x, y))
__device__ __forceinline__ float wave_sum(float v) {
    v += dpp_f<0xB1>(v);
    v += dpp_f<0x4E>(v);
    v += dpp_f<0x141>(v);
    v += dpp_f<0x140>(v);
    v = xor16_sum(v);
    return xor32_sum(v);
}
__device__ __forceinline__ float silu_f(float x) { return x * __builtin_amdgcn_rcpf(1.f + __expf(-x)); }
__device__ __forceinline__ int modrow_of(int row) { return row < TC ? 0 : 1 + ((row - TC) >> 11); }

namespace pg8 {
constexpr int BM = 256, BK = 64, HALF = 128, HTB = HALF * BK * 2, STAGE_BYTES = 8 * HTB, NXCD = 8, WGM = 8;
__device__ __forceinline__ int lds_byte(int r, int c) { const int st = (r >> 4) * 2 + (c >> 5), rr = r & 15, cc = c & 31, ob = rr * 64 + cc * 2; return st * 1024 + (ob ^ (((ob >> 9) & 1) << 5)); }
__device__ __forceinline__ void stage_rc(int b, int& R, int& C) { const int st = b / 1024, sb = b % 1024, swz = sb ^ (((sb >> 9) & 1) << 5); R = (st >> 1) * 16 + swz / 64; C = (st & 1) * 32 + (swz % 64) / 2; }
__device__ __forceinline__ int perm32(int rho) { const int n = rho >> 4, i = rho & 15; return 8 * (i >> 2) + 4 * n + (i & 3); }

struct Unit { int pm, pn, z; };
struct Gemm { const bf16_t* A; const bf16_t* Bt; int M, N, K, ld, nz; size_t zA, zB; };

struct Order {
    int nM, nN, nwg, nz, G, c;
    __device__ void init(int M, int N, int nz_, int G_, int c_) { nM = M / BM; nN = N / BM; nwg = nM * nN; nz = nz_; G = G_; c = c_; }
    __device__ bool next(int i, Unit& u) const {
        const long L = (long)i * G + c; if (L >= (long)nwg * nz) return false;
        u.z = (int)(L / nwg); int wgid = (int)(L % nwg);
        { const int q = nwg / NXCD, r = nwg % NXCD, xcd = wgid % NXCD, off = wgid / NXCD; wgid = (xcd < r ? xcd * (q + 1) : r * (q + 1) + (xcd - r) * q) + off; }
        const int nig = WGM * nN, gid = wgid / nig, fm = gid * WGM, gsz = (nM - fm) < WGM ? (nM - fm) : WGM;
        u.pm = fm + ((wgid % nig) % gsz); u.pn = (wgid % nig) / gsz; return true;
    }
};

typedef f32x4 Acc[2][2][4][2];

struct EpiStoreF32 {
    static constexpr bool PERM = false;
    float* C; int ldc;
    __device__ __forceinline__ void operator()(const Acc& acc, const Unit& u, int wr, int wc, int fr, int fq) const {
        const int row0 = u.pm * BM + wr * 64 + fr, col0 = u.pn * BM + wc * 32 + 4 * fq;
#pragma unroll
        for (int ai = 0; ai < 2; ++ai)
#pragma unroll
            for (int m = 0; m < 4; ++m) { float* rowp = C + (size_t)(row0 + ai * HALF + m * 16) * ldc + col0;
#pragma unroll
                for (int bj = 0; bj < 2; ++bj)
#pragma unroll
                    for (int n = 0; n < 2; ++n) *(f32x4*)(rowp + bj * HALF + n * 16) = acc[ai][bj][m][n]; }
    }
};
struct EpiStoreBf16 {
    static constexpr bool PERM = true;
    bf16_t* O; int ldc; float scale; size_t zoff; int pm_stride;
    __device__ __forceinline__ void operator()(const Acc& acc, const Unit& u, int wr, int wc, int fr, int fq) const {
        const int row0 = u.pm * pm_stride + wr * 64 + fr, col0 = u.pn * BM + wc * 32 + 8 * fq;
        bf16_t* base = O + (size_t)u.z * zoff;
#pragma unroll
        for (int ai = 0; ai < 2; ++ai)
#pragma unroll
            for (int m = 0; m < 4; ++m) { bf16_t* rowp = base + (size_t)(row0 + ai * HALF + m * 16) * ldc + col0;
#pragma unroll
                for (int bj = 0; bj < 2; ++bj) { const f32x4 v0 = acc[ai][bj][m][0] * scale, v1 = acc[ai][bj][m][1] * scale;
                    u32x4 o; o.x = cvt_pk_bf16(v0[0], v0[1]); o.y = cvt_pk_bf16(v0[2], v0[3]); o.z = cvt_pk_bf16(v1[0], v1[1]); o.w = cvt_pk_bf16(v1[2], v1[3]);
                    *(u32x4*)(rowp + bj * HALF) = o; } }
    }
};
struct EpiSwiGLU {
    static constexpr bool PERM = true;
    bf16_t* H;
    __device__ __forceinline__ void operator()(const Acc& acc, const Unit& u, int wr, int wc, int fr, int fq) const {
        const int row0 = u.pm * BM + wr * 64 + fr, col0 = u.pn * HALF + wc * 32 + 8 * fq;
#pragma unroll
        for (int ai = 0; ai < 2; ++ai)
#pragma unroll
            for (int m = 0; m < 4; ++m) { bf16_t* rowp = H + (size_t)(row0 + ai * HALF + m * 16) * FF + col0;
                const f32x4 g0 = acc[ai][0][m][0], g1 = acc[ai][0][m][1], u0 = acc[ai][1][m][0], u1 = acc[ai][1][m][1];
                u32x4 o; o.x = cvt_pk_bf16(silu_f(g0[0]) * u0[0], silu_f(g0[1]) * u0[1]); o.y = cvt_pk_bf16(silu_f(g0[2]) * u0[2], silu_f(g0[3]) * u0[3]);
                o.z = cvt_pk_bf16(silu_f(g1[0]) * u1[0], silu_f(g1[1]) * u1[1]); o.w = cvt_pk_bf16(silu_f(g1[2]) * u1[2], silu_f(g1[3]) * u1[3]);
                *(u32x4*)rowp = o; }
    }
};
struct EpiResid {
    static constexpr bool PERM = false;
    const float* Y; float* Z; float* Z1; const float* gate; float gs;
    __device__ __forceinline__ void operator()(const Acc& acc, const Unit& u, int wr, int wc, int fr, int fq) const {
        const int row0 = u.pm * BM + wr * 64 + fr, col0 = u.pn * BM + wc * 32 + 4 * fq;
        const int mr = u.pm < 16 ? 0 : 1 + ((u.pm - 16) >> 3);
        const float* gp = gate + (size_t)mr * 9216 + col0;
        f32x4 gv[2][2];
#pragma unroll
        for (int bj = 0; bj < 2; ++bj)
#pragma unroll
            for (int n = 0; n < 2; ++n) gv[bj][n] = *(const f32x4*)(gp + bj * HALF + n * 16) * gs;
#pragma unroll
        for (int ai = 0; ai < 2; ++ai)
#pragma unroll
            for (int m = 0; m < 4; ++m) { const size_t ro = (size_t)(row0 + ai * HALF + m * 16) * D + col0;
#pragma unroll
                for (int bj = 0; bj < 2; ++bj)
#pragma unroll
                    for (int n = 0; n < 2; ++n) {
                        if (u.z == 0) { const f32x4 y = *(const f32x4*)(Y + ro + bj * HALF + n * 16);
                            *(f32x4*)(Z + ro + bj * HALF + n * 16) = y * ALPHA + gv[bj][n] * acc[ai][bj][m][n]; }
                        else *(f32x4*)(Z1 + ro + bj * HALF + n * 16) = gv[bj][n] * acc[ai][bj][m][n]; } }
    }
};
struct EpiQb {
    static constexpr bool PERM = true;
    bf16_t* O;
    __device__ __forceinline__ void operator()(const Acc& acc, const Unit& u, int wr, int wc, int fr, int fq) const {
        const int row0 = u.pm * BM + wr * 64 + fr, col0 = u.pn * BM + wc * 32 + 8 * fq;
        const bool lat = u.pm >= 16;
#pragma unroll
        for (int bj = 0; bj < 2; ++bj) {
            const int g32 = (u.pn * BM + bj * HALF + wc * 32) >> 5;
            const bool rope = lat && (g32 % 3 == 2);
#pragma unroll
            for (int ai = 0; ai < 2; ++ai)
#pragma unroll
                for (int m = 0; m < 4; ++m) {
                    const int row = row0 + ai * HALF + m * 16;
                    f32x4 v0 = acc[ai][bj][m][0], v1 = acc[ai][bj][m][1];
                    if (rope) {
                        const int l = (row - TC) & 2047;
                        const float pos = (float)((fq < 2) ? (l >> 6) : (l & 63));
                        const float sgn = (fq & 1) ? 1.f : -1.f;
#pragma unroll
                        for (int i = 0; i < 8; ++i) {
                            const float own = i < 4 ? v0[i & 3] : v1[i & 3];
                            const float oth = __shfl_xor(own, 16);
                            const float rev = pos * (__builtin_amdgcn_exp2f(-(float)i * (LOG2_10000 / 8.f)) * INV2PI);
                            const float cs = __builtin_amdgcn_cosf(rev), sn = __builtin_amdgcn_sinf(rev);
                            const float r = own * cs + sgn * oth * sn;
                            if (i < 4) v0[i & 3] = r; else v1[i & 3] = r;
                        }
                    }
                    v0 = v0 * QB_SCALE; v1 = v1 * QB_SCALE;
                    u32x4 o; o.x = cvt_pk_bf16(v0[0], v0[1]); o.y = cvt_pk_bf16(v0[2], v0[3]); o.z = cvt_pk_bf16(v1[0], v1[1]); o.w = cvt_pk_bf16(v1[2], v1[3]);
                    *(u32x4*)(O + (size_t)row * 768 + col0 + bj * HALF) = o;
                }
        }
    }
};
struct EpiPt {
    static constexpr bool PERM = true;
    bf16_t* PtL; bf16_t* PtC;
    __device__ __forceinline__ void operator()(const Acc& acc, const Unit& u, int wr, int wc, int fr, int fq) const {
        const int row0 = u.pm * BM + wr * 64 + fr, col0 = u.pn * BM + wc * 32 + 8 * fq;
#pragma unroll
        for (int ai = 0; ai < 2; ++ai)
#pragma unroll
            for (int m = 0; m < 4; ++m) { const int np = row0 + ai * HALF + m * 16, s = np >> 10, n = np & 1023;
#pragma unroll
                for (int bj = 0; bj < 2; ++bj) { const int t = col0 + bj * HALF;
                    bf16_t* dst;
                    if (t < TC) { const int bc = t >> 8, l = t & 255; dst = PtC + ((size_t)(bc * 1024 + n)) * 512 + s * 256 + l; }
                    else { const int tl = t - TC, b = tl >> 11, l = tl & 2047; dst = PtL + ((size_t)(b * 1024 + n)) * 4096 + s * 2048 + l; }
                    const f32x4 v0 = acc[ai][bj][m][0], v1 = acc[ai][bj][m][1];
                    u32x4 o; o.x = cvt_pk_bf16(v0[0], v0[1]); o.y = cvt_pk_bf16(v0[2], v0[3]); o.z = cvt_pk_bf16(v1[0], v1[1]); o.w = cvt_pk_bf16(v1[2], v1[3]);
                    *(u32x4*)dst = o; } }
    }
};

template <class Epi>
__device__ __forceinline__ void gemm_phase(LAS unsigned char* lds, const Gemm g, const Order& S, const Epi& E) {
    const int tid = ltid(), wid = __builtin_amdgcn_readfirstlane(tid >> 6), lane = tid & 63, wr = wid >> 2, wc = wid & 3, fr = lane & 15, fq = lane >> 4;
    const int K = g.ld, nt = g.K / BK;
    unsigned voffA[2], voffB[2];
#pragma unroll
    for (int i = 0; i < 2; ++i) { int R, C; stage_rc(tid * 16 + i * 8192, R, C); const int Rb = Epi::PERM ? ((R & ~31) + perm32(R & 31)) : R;
        voffA[i] = (unsigned)(R * K + C) * 2u; voffB[i] = (unsigned)(Rb * K + C) * 2u; }
    const size_t kstep = (size_t)(BK * 2);
    const size_t hstep = (size_t)HALF * K * 2;
    const size_t tstep = 2 * hstep;
    const unsigned ldsw = (unsigned)wid * 1024u;
    const int aoff = lds_byte(wr * 64 + fr, fq * 8), boff = lds_byte(wc * 32 + fr, fq * 8);
#define PG8_SA(b, h) (((b) * 2 + (h)) * HTB)
#define PG8_SB(b, h) ((4 + (b) * 2 + (h)) * HTB)
#define PG8_STAGE(bufoff, gbase, voff) do { _Pragma("unroll") for (int _i = 0; _i < 2; ++_i) \
        __builtin_amdgcn_global_load_lds((const unsigned*)((const char*)(gbase) + (voff)[_i]), (LAS unsigned*)(lds + (bufoff) + ldsw + _i * 8192), 16, 0, 0); } while (0)
#define PG8_LDA(dst, b, h) do { _Pragma("unroll") for (int m = 0; m < 4; ++m) _Pragma("unroll") for (int k = 0; k < 2; ++k) dst[m][k] = *(const LAS bf16x8*)(lds + PG8_SA(b, h) + aoff + m * 2048 + k * 1024); } while (0)
#define PG8_LDB(dst, b, h) do { _Pragma("unroll") for (int n = 0; n < 2; ++n) _Pragma("unroll") for (int k = 0; k < 2; ++k) dst[n][k] = *(const LAS bf16x8*)(lds + PG8_SB(b, h) + boff + n * 2048 + k * 1024); } while (0)
#define PG8_MMA(ai, bj, At, Bt) do { __builtin_amdgcn_s_setprio(1); _Pragma("unroll") for (int m = 0; m < 4; ++m) _Pragma("unroll") for (int n = 0; n < 2; ++n) _Pragma("unroll") for (int k = 0; k < 2; ++k) \
        acc[ai][bj][m][n] = __builtin_amdgcn_mfma_f32_16x16x32_bf16(Bt[n][k], At[m][k], acc[ai][bj][m][n], 0, 0, 0); __builtin_amdgcn_s_setprio(0); } while (0)
#define PG8_WAIT_V(n) asm volatile("s_waitcnt vmcnt(" #n ")" ::: "memory")
#define PG8_WAIT_L(n) asm volatile("s_waitcnt lgkmcnt(" #n ")" ::: "memory")
#define PG8_BAR __builtin_amdgcn_s_barrier()
#define PG8_SCHED __builtin_amdgcn_sched_barrier(0)
    Unit cur, nxt; int ui = 0;
    if (!S.next(0, cur)) return;
    Acc acc;
#pragma unroll
    for (int a = 0; a < 2; ++a)
#pragma unroll
        for (int b = 0; b < 2; ++b)
#pragma unroll
            for (int m = 0; m < 4; ++m)
#pragma unroll
                for (int n = 0; n < 2; ++n) acc[a][b][m][n] = (f32x4){0.f, 0.f, 0.f, 0.f};
    bf16x8 At[4][2], B0[2][2], B1[2][2];
    const char* cA = (const char*)g.A + (size_t)cur.z * g.zA + (size_t)cur.pm * tstep; const char* cB = (const char*)g.Bt + (size_t)cur.z * g.zB + (size_t)cur.pn * tstep;
    PG8_STAGE(PG8_SB(0, 0), cB, voffB); PG8_STAGE(PG8_SB(0, 1), cB + hstep, voffB); PG8_STAGE(PG8_SA(0, 0), cA, voffA); PG8_STAGE(PG8_SA(0, 1), cA + hstep, voffA);
    if (wr == 1) PG8_BAR;
    PG8_WAIT_V(2); PG8_BAR;
    PG8_STAGE(PG8_SB(1, 0), cB + kstep, voffB); PG8_STAGE(PG8_SA(1, 0), cA + kstep, voffA); PG8_STAGE(PG8_SB(1, 1), cB + hstep + kstep, voffB);
    PG8_WAIT_V(6); PG8_BAR;
    for (;;) {
        const bool has_next = S.next(ui + 1, nxt);
        const char* nA = has_next ? (const char*)g.A + (size_t)nxt.z * g.zA + (size_t)nxt.pm * tstep : cA; const char* nB = has_next ? (const char*)g.Bt + (size_t)nxt.z * g.zB + (size_t)nxt.pn * tstep : cB;
        for (int t = 0; t < nt; t += 2) {
            const bool last = (t == nt - 2);
            const char* a1 = cA + (size_t)(t + 1) * kstep;
            const char* a2 = last ? nA : cA + (size_t)(t + 2) * kstep; const char* b2 = last ? nB : cB + (size_t)(t + 2) * kstep;
            const char* a3 = a2 + kstep; const char* b3 = b2 + kstep;
            PG8_LDB(B0, 0, 0); PG8_LDB(B1, 0, 1); PG8_SCHED; PG8_LDA(At, 0, 0); PG8_STAGE(PG8_SA(1, 1), a1 + hstep, voffA);
            PG8_WAIT_V(8); PG8_WAIT_L(0); PG8_BAR; PG8_MMA(0, 0, At, B0); PG8_MMA(0, 1, At, B1); PG8_BAR; PG8_SCHED;
            PG8_LDA(At, 0, 1); PG8_STAGE(PG8_SB(0, 0), b2, voffB); PG8_STAGE(PG8_SB(0, 1), b2 + hstep, voffB); PG8_STAGE(PG8_SA(0, 0), a2, voffA);
            PG8_WAIT_V(8); PG8_WAIT_L(0); PG8_BAR; PG8_MMA(1, 0, At, B0); PG8_MMA(1, 1, At, B1); PG8_BAR; PG8_SCHED;
            PG8_LDB(B0, 1, 0); PG8_LDB(B1, 1, 1); PG8_SCHED; PG8_LDA(At, 1, 0); PG8_STAGE(PG8_SA(0, 1), a2 + hstep, voffA);
            PG8_WAIT_V(8); PG8_WAIT_L(0); PG8_BAR; PG8_MMA(0, 0, At, B0); PG8_MMA(0, 1, At, B1); PG8_BAR; PG8_SCHED;
            PG8_LDA(At, 1, 1); PG8_STAGE(PG8_SB(1, 0), b3, voffB); PG8_STAGE(PG8_SB(1, 1), b3 + hstep, voffB); PG8_STAGE(PG8_SA(1, 0), a3, voffA);
            PG8_WAIT_V(8); PG8_WAIT_L(0); PG8_BAR; PG8_MMA(1, 0, At, B0); PG8_MMA(1, 1, At, B1); PG8_BAR; PG8_SCHED;
        }
        if (wr == 0) PG8_BAR;
        E(acc, cur, wr, wc, fr, fq);
        if (!has_next) break;
#pragma unroll
        for (int a = 0; a < 2; ++a)
#pragma unroll
            for (int b = 0; b < 2; ++b)
#pragma unroll
                for (int m = 0; m < 4; ++m)
#pragma unroll
                    for (int n = 0; n < 2; ++n) acc[a][b][m][n] = (f32x4){0.f, 0.f, 0.f, 0.f};
        cur = nxt; cA = nA; cB = nB; ++ui;
        if (wr == 1) PG8_BAR;
    }
    PG8_WAIT_V(0);
    PG8_BAR;
#undef PG8_SA
#undef PG8_SB
#undef PG8_STAGE
#undef PG8_LDA
#undef PG8_LDB
#undef PG8_MMA
#undef PG8_WAIT_V
#undef PG8_WAIT_L
#undef PG8_BAR
#undef PG8_SCHED
}
}

constexpr int LF_TILES = 3 * 16 * 44;
__device__ __forceinline__ void transpose_range(KP p, LAS unsigned char* lds, int t0, int t1, int w, int nw) {
    const int tid = ltid();
    LAS float* s = (LAS float*)lds;
    int j = 0;
    for (int tile = t0 + w; tile < t1; tile += nw) {
        while (j + 1 < NJOBS && tile >= p->jobs[j + 1].tile0) ++j;
        const __attribute__((address_space(4))) TJob& J = p->jobs[j];
        const int lt = tile - J.tile0, ntn = J.ncols >> 6, tk = lt / ntn, tn = lt % ntn, k0 = tk * 64, n0 = tn * 64;
        const int scol0 = (n0 / J.sblk) * J.sstride + (n0 % J.sblk) + J.soff;
        const int drow0 = (n0 / J.dblk) * J.dstride + (n0 % J.dblk) + J.doff;
        __syncthreads();
#pragma unroll
        for (int i = 0; i < 8; ++i) { const int idx = tid + 512 * i, kk = idx >> 6, nn = idx & 63;
            const float v = (n0 + nn < J.nvalid) ? J.src[(size_t)(k0 + kk) * J.lds + scol0 + nn] : 0.f;
            s[kk * 65 + nn] = v; }
        __syncthreads();
        { const int n = tid >> 3, ch = tid & 7; const LAS float* sp = s + (8 * ch) * 65 + n;
            u32x4 o; o.x = cvt_pk_bf16(sp[0], sp[65]); o.y = cvt_pk_bf16(sp[2 * 65], sp[3 * 65]); o.z = cvt_pk_bf16(sp[4 * 65], sp[5 * 65]); o.w = cvt_pk_bf16(sp[6 * 65], sp[7 * 65]);
            *(u32x4*)(J.dst + (size_t)(drow0 + n) * J.K + k0 + 8 * ch) = o; }
    }
}
__device__ __forceinline__ void phase_p0(KP p, LAS unsigned char* lds) {
    const int tid = ltid(), bid = blockIdx.x, G = gridDim.x;
    unsigned char* ws = p->ws;
    {
        LAS float* s = (LAS float*)lds;
        float* modp = (float*)(ws + OFF_SCR + SCR_MODP);
        for (int item = bid; item < 576; item += G) {
            const int l = item / 144, rem = item % 144, cb = rem >> 3, kc = rem & 7;
            __syncthreads();
            for (int idx = tid; idx < 9 * 128; idx += 512) { const int r = idx >> 7, k = idx & 127;
                const float x = (r == 0) ? p->c_ctx[kc * 128 + k] : p->c[(r - 1) * 1024 + kc * 128 + k];
                s[idx] = x / (1.f + __expf(-x)); }
            __syncthreads();
            const int col = cb * 512 + tid;
            const float* w = p->w_ada + ((size_t)l * 1024 + kc * 128) * 9216 + col;
            float a0 = 0.f, a1 = 0.f, a2 = 0.f, a3 = 0.f, a4 = 0.f, a5 = 0.f, a6 = 0.f, a7 = 0.f, a8 = 0.f;
            for (int kb = 0; kb < 128; kb += 32) {
                float wv[32];
#pragma unroll
                for (int k = 0; k < 32; ++k) wv[k] = w[(size_t)(kb + k) * 9216];
#pragma unroll
                for (int k = 0; k < 32; ++k) { const int kk = kb + k;
                    a0 += s[kk] * wv[k]; a1 += s[128 + kk] * wv[k]; a2 += s[256 + kk] * wv[k]; a3 += s[384 + kk] * wv[k]; a4 += s[512 + kk] * wv[k];
                    a5 += s[640 + kk] * wv[k]; a6 += s[768 + kk] * wv[k]; a7 += s[896 + kk] * wv[k]; a8 += s[1024 + kk] * wv[k]; }
            }
            float* o = modp + ((size_t)(kc * 4 + l) * 9) * 9216 + col;
            o[0] = a0; o[9216] = a1; o[2 * 9216] = a2; o[3 * 9216] = a3; o[4 * 9216] = a4; o[5 * 9216] = a5; o[6 * 9216] = a6; o[7 * 9216] = a7; o[8 * 9216] = a8;
        }
    }
    transpose_range(p, lds, 0, 2 * LF_TILES, bid, G);
    transpose_range(p, lds, 8 * LF_TILES, p->ntiles_total, bid, G);
    const size_t gtid = (size_t)bid * 512 + tid, gsz = (size_t)G * 512;
    {
        bf16_t* dst = (bf16_t*)(ws + OFF_WFING);
        for (size_t e = gtid; e < (size_t)2 * 1024 * 1024 / 4; e += gsz) {
            const size_t e4 = e * 4; const int i = (int)(e4 >> 20), k = (int)((e4 >> 10) & 1023), col = (int)(e4 & 1023), g = col >> 8, c = col & 255;
            const f32x4 v = *(const f32x4*)(p->f_w_in + e4);
            u32x2 o; o.x = cvt_pk_bf16(v[0], v[1]); o.y = cvt_pk_bf16(v[2], v[3]);
            *(u32x2*)(dst + (((size_t)(i * 4 + g) * 1024 + k) << 8) + c) = o;
        }
    }
    {
        bf16_t* cst = (bf16_t*)(ws + OFF_CST);
        for (size_t e = gtid; e < (size_t)512 * 256; e += gsz) { const int r = (int)(e >> 8), c = (int)(e & 255), s = r >> 8, m = r & 255;
            const float rev = (float)((m * c) & 255) * (1.f / 256.f);
            cst[e] = f2bf(s ? __builtin_amdgcn_sinf(rev) : __builtin_amdgcn_cosf(rev)); }
        bf16_t* twl = (bf16_t*)(ws + OFF_TWLAT);
        for (size_t e = gtid; e < (size_t)2048 * 4096; e += gsz) { const int kf = (int)(e >> 12), cc = (int)(e & 4095), s = cc >> 11, l = cc & 2047;
            const float rev = (float)((kf * l) & 2047) * (1.f / 2048.f);
            twl[e] = f2bf(s ? -__builtin_amdgcn_sinf(rev) : __builtin_amdgcn_cosf(rev)); }
        bf16_t* twc = (bf16_t*)(ws + OFF_TWCTX);
        for (size_t e = gtid; e < (size_t)256 * 512; e += gsz) { const int kf = (int)(e >> 9), cc = (int)(e & 511), s = cc >> 8, l = cc & 255;
            const float rev = (float)((kf * l) & 255) * (1.f / 256.f);
            twc[e] = f2bf(s ? -__builtin_amdgcn_sinf(rev) : __builtin_amdgcn_cosf(rev)); }
    }
}
__device__ __forceinline__ void phase_p1_mods(KP p) {
    const size_t gtid = (size_t)blockIdx.x * 512 + ltid(), gsz = (size_t)gridDim.x * 512;
    const float* modp = (const float*)(p->ws + OFF_SCR + SCR_MODP);
    float* mods = (float*)(p->ws + OFF_MODS);
    for (size_t e = gtid; e < (size_t)4 * 9 * 9216; e += gsz) {
        const int l = (int)(e / (9 * 9216)), n = (int)(e % 9216);
        float a = p->b_ada[l * 9216 + n];
#pragma unroll
        for (int kc = 0; kc < 8; ++kc) a += modp[(size_t)kc * 4 * 9 * 9216 + e];
        mods[e] = a;
    }
}
__device__ __forceinline__ f32x4 bf4_to_f32(u32x2 u) { f32x4 r; r[0] = __uint_as_float(u.x << 16); r[1] = __uint_as_float(u.x & 0xffff0000u); r[2] = __uint_as_float(u.y << 16); r[3] = __uint_as_float(u.y & 0xffff0000u); return r; }
template <bool DO_LN>
__device__ __forceinline__ void phase_ln(KP p, const float* g_, const float* b_, const float* gate, const float* shift, const float* scale, bool write_h) {
    constexpr int NR = 2;
    const int lane = ltid() & 63, wave = ltid() >> 6;
    const bf16_t* BR = (const bf16_t*)(p->ws + OFF_SCR + SCR_Z1);
    bf16_t* H = (bf16_t*)(p->ws + OFF_HMOD); _Float16* YB = (_Float16*)(p->ws + OFF_Z);
    const int stride = gridDim.x * 8;
    for (int row0 = blockIdx.x * 8 + wave; row0 < T; row0 += NR * stride) {
        f32x4 v[NR][4];
#pragma unroll
        for (int r = 0; r < NR; ++r) { const int row = row0 + r * stride;
            if (row < T) {
                if (DO_LN) {
                    const float* gp = gate + (size_t)modrow_of(row) * 9216;
#pragma unroll
                    for (int j = 0; j < 4; ++j) { const size_t o = (size_t)row * D + 4 * lane + 256 * j;
                        const f32x4 y = __builtin_convertvector(*(const f16x4_t*)(YB + o), f32x4);
                        const f32x4 b0 = bf4_to_f32(*(const u32x2*)(BR + o)), b1 = bf4_to_f32(*(const u32x2*)(BR + (size_t)T * D + o));
                        v[r][j] = y * ALPHA + *(const f32x4*)(gp + 4 * lane + 256 * j) * (b0 + b1); }
                } else { const float* src = row < TC ? p->x_prompt + (size_t)row * D : p->x_sample + (size_t)(row - TC) * D;
#pragma unroll
                    for (int j = 0; j < 4; ++j) v[r][j] = *(const f32x4*)(src + 4 * lane + 256 * j); }
            } else {
#pragma unroll
                for (int j = 0; j < 4; ++j) v[r][j] = (f32x4){0.f, 0.f, 0.f, 0.f};
            } }
#pragma unroll
        for (int r = 0; r < NR; ++r) { const int row = row0 + r * stride;
            if (row >= T) break;
            if (DO_LN) {
                float s = 0.f;
#pragma unroll
                for (int j = 0; j < 4; ++j) s += (v[r][j][0] + v[r][j][1]) + (v[r][j][2] + v[r][j][3]);
                const float mean = wave_sum(s) * (1.f / D);
                float s2 = 0.f;
#pragma unroll
                for (int j = 0; j < 4; ++j) { v[r][j] = v[r][j] - mean; s2 += (v[r][j][0] * v[r][j][0] + v[r][j][1] * v[r][j][1]) + (v[r][j][2] * v[r][j][2] + v[r][j][3] * v[r][j][3]); }
                const float rstd = __builtin_amdgcn_rsqf(wave_sum(s2) * (1.f / D) + 1e-5f);
#pragma unroll
                for (int j = 0; j < 4; ++j) { const f32x4 gg = *(const f32x4*)(g_ + 4 * lane + 256 * j), bb = *(const f32x4*)(b_ + 4 * lane + 256 * j); v[r][j] = v[r][j] * rstd * gg + bb; }
            }
            if (write_h) {
#pragma unroll
                for (int j = 0; j < 4; ++j) *(f16x4_t*)(YB + (size_t)row * D + 4 * lane + 256 * j) = __builtin_convertvector(v[r][j], f16x4_t);
            } else {
                float* y = p->out + (size_t)row * D;
#pragma unroll
                for (int j = 0; j < 4; ++j) *(f32x4*)(y + 4 * lane + 256 * j) = v[r][j];
            }
            if (write_h) {
                const int mr = modrow_of(row);
#pragma unroll
                for (int j = 0; j < 4; ++j) { const f32x4 sh = *(const f32x4*)(shift + (size_t)mr * 9216 + 4 * lane + 256 * j), sc = *(const f32x4*)(scale + (size_t)mr * 9216 + 4 * lane + 256 * j);
                    const f32x4 h = v[r][j] * (sc + 1.f) + sh;
                    u32x2 o; o.x = cvt_pk_bf16(h[0], h[1]); o.y = cvt_pk_bf16(h[2], h[3]);
                    *(u32x2*)(H + (size_t)row * D + 4 * lane + 256 * j) = o; }
            }
        }
    }
}

__device__ __forceinline__ void phase_postproj(KP p, int i) {
    const int lane = ltid() & 63, wave = ltid() >> 6;
    unsigned char* scr = p->ws + OFF_SCR;
    const bf16_t* proj = (const bf16_t*)(scr + SCR_PROJ);
    bf16_t* QA = (bf16_t*)(scr + SCR_QA); bf16_t* KA = (bf16_t*)(scr + SCR_KA); bf16_t* VAT = (bf16_t*)(scr + SCR_VAT);
    bf16_t* CQN = (bf16_t*)(scr + SCR_CQN); bf16_t* CKVN = (bf16_t*)(scr + SCR_CKVN); bf16_t* KPE = (bf16_t*)(scr + SCR_KPE);
    for (int kr = blockIdx.x * 8 + wave; kr < KR; kr += gridDim.x * 8) {
        int t, l = 0; bool ctx;
        if (kr < TC) { t = kr; ctx = true; l = kr & 255; }
        else {
            const int b = (kr - TC) / 2304, j = (kr - TC) % 2304;
            if (j < 256) {
                const size_t cr = (size_t)((b * 2 + i) * 256 + j);
                const float* ck = p->cache_a_k + cr * 128; const float* cv = p->cache_a_v + cr * 128;
                KA[(size_t)kr * 128 + lane] = f2bf(ck[lane]); KA[(size_t)kr * 128 + 64 + lane] = f2bf(ck[64 + lane]);
                VAT[(size_t)lane * KR + kr] = f2bf(cv[lane]); VAT[(size_t)(64 + lane) * KR + kr] = f2bf(cv[64 + lane]);
                const f32x4 cc = *(const f32x4*)(p->cache_b_ckv + cr * 256 + 4 * lane);
                u32x2 o; o.x = cvt_pk_bf16(cc[0], cc[1]); o.y = cvt_pk_bf16(cc[2], cc[3]);
                *(u32x2*)(CKVN + (size_t)kr * 256 + 4 * lane) = o;
                if (lane < 32) KPE[(size_t)kr * 32 + lane] = f2bf(p->cache_b_kpe[cr * 32 + lane]);
                continue;
            }
            l = j - 256; t = TC + b * 2048 + l; ctx = false;
        }
        const bf16_t* srcb = proj + (size_t)t * 1536;
#define PJ(i_) __uint_as_float(((unsigned)srcb[(i_)]) << 16)
        const float prow = (float)(l >> 6), pcol = (float)(l & 63);
#pragma unroll
        for (int q = 0; q < 4; ++q) { const int pidx = lane + 64 * q, head = pidx >> 5, pp = pidx & 31, d1 = pp < 16 ? pp : pp + 16, d2 = d1 + 16;
            float x1 = PJ(head * 64 + d1), x2 = PJ(head * 64 + d2);
            if (!ctx) { const float rev = (pp < 16 ? prow : pcol) * (__builtin_amdgcn_exp2f(-(float)(pp & 15) * (LOG2_10000 / 16.f)) * INV2PI);
                const float cs = __builtin_amdgcn_cosf(rev), sn = __builtin_amdgcn_sinf(rev);
                const float o1 = x1 * cs - x2 * sn, o2 = x2 * cs + x1 * sn; x1 = o1; x2 = o2; }
            QA[(size_t)t * 512 + head * 64 + d1] = f2bf(x1 * QA_SCALE); QA[(size_t)t * 512 + head * 64 + d2] = f2bf(x2 * QA_SCALE); }
        { const int head = lane >> 5, pp = lane & 31, d1 = pp < 16 ? pp : pp + 16, d2 = d1 + 16;
            float x1 = PJ(512 + head * 64 + d1), x2 = PJ(512 + head * 64 + d2);
            if (ctx) { float* o = p->out + O_AK + ((size_t)(((kr >> 8) * 2 + i) * 256 + l)) * 128 + head * 64; o[d1] = x1; o[d2] = x2; }
            else { const float rev = (pp < 16 ? prow : pcol) * (__builtin_amdgcn_exp2f(-(float)(pp & 15) * (LOG2_10000 / 16.f)) * INV2PI);
                const float cs = __builtin_amdgcn_cosf(rev), sn = __builtin_amdgcn_sinf(rev);
                const float o1 = x1 * cs - x2 * sn, o2 = x2 * cs + x1 * sn; x1 = o1; x2 = o2; }
            KA[(size_t)kr * 128 + head * 64 + d1] = f2bf(x1); KA[(size_t)kr * 128 + head * 64 + d2] = f2bf(x2); }
        { const float v0 = PJ(640 + lane), v1 = PJ(704 + lane);
            VAT[(size_t)lane * KR + kr] = f2bf(v0); VAT[(size_t)(64 + lane) * KR + kr] = f2bf(v1);
            if (ctx) { float* o = p->out + O_AV + ((size_t)(((kr >> 8) * 2 + i) * 256 + l)) * 128; o[lane] = v0; o[64 + lane] = v1; } }
        { float x[6]; float ss = 0.f;
#pragma unroll
            for (int q = 0; q < 6; ++q) { x[q] = PJ(768 + lane + 64 * q); ss += x[q] * x[q]; }
            const float r = __builtin_amdgcn_rsqf(wave_sum(ss) * (1.f / 384.f) + 1e-6f);
#pragma unroll
            for (int q = 0; q < 6; ++q) CQN[(size_t)t * 384 + lane + 64 * q] = f2bf(x[q] * r * p->b_g_cq[i * 384 + lane + 64 * q]); }
        { const f32x4 x = bf4_to_f32(*(const u32x2*)(srcb + 1152 + 4 * lane));
            const float ss = (x[0] * x[0] + x[1] * x[1]) + (x[2] * x[2] + x[3] * x[3]);
            const float r = __builtin_amdgcn_rsqf(wave_sum(ss) * (1.f / 256.f) + 1e-6f);
            const f32x4 g = *(const f32x4*)(p->b_g_ckv + i * 256 + 4 * lane);
            const f32x4 y = x * r * g;
            u32x2 o; o.x = cvt_pk_bf16(y[0], y[1]); o.y = cvt_pk_bf16(y[2], y[3]);
            *(u32x2*)(CKVN + (size_t)kr * 256 + 4 * lane) = o;
            if (ctx) *(f32x4*)(p->out + O_CKV + ((size_t)(((kr >> 8) * 2 + i) * 256 + l)) * 256 + 4 * lane) = y; }
        if (lane < 16) { const int d1 = lane < 8 ? lane : lane + 8, d2 = d1 + 8;
            float x1 = PJ(1408 + d1), x2 = PJ(1408 + d2);
            if (ctx) { float* o = p->out + O_KPE + ((size_t)(((kr >> 8) * 2 + i) * 256 + l)) * 32; o[d1] = x1; o[d2] = x2; }
            else { const float rev = (lane < 8 ? prow : pcol) * (__builtin_amdgcn_exp2f(-(float)(lane & 7) * (LOG2_10000 / 8.f)) * INV2PI);
                const float cs = __builtin_amdgcn_cosf(rev), sn = __builtin_amdgcn_sinf(rev);
                const float o1 = x1 * cs - x2 * sn, o2 = x2 * cs + x1 * sn; x1 = o1; x2 = o2; }
            KPE[(size_t)kr * 32 + d1] = f2bf(x1); KPE[(size_t)kr * 32 + d2] = f2bf(x2); }
    }
}

#undef PJ
template <bool IS_B>
__device__ __forceinline__ void attn_item(LAS unsigned char* lds, KP p, bool lat, int b, int h, int qblk, int li) {
    constexpr int DQK = IS_B ? 96 : 64, KSTR = DQK + 8, VSTR = 72;
    unsigned char* scr = p->ws + OFF_SCR;
    const int tid = ltid(), wave = tid >> 6, lane = tid & 63, qi = lane & 15, quad = lane >> 4;
    int q_tok0, kbase, ntiles, lo = 0;
    if (lat) { q_tok0 = TC + b * 2048 + qblk * 256; kbase = TC + b * 2304;
        if (IS_B) ntiles = 36; else { lo = qblk * 256 - 128; if (lo < 0) lo = 0; int hi = qblk * 256 + 384; if (hi > 2048) hi = 2048; ntiles = 4 + ((hi - lo) >> 6); } }
    else { q_tok0 = b * 256; kbase = b * 256; ntiles = 4; }
    const bf16_t* Q = (const bf16_t*)(scr + (IS_B ? SCR_QB : SCR_QA)); constexpr int ldq = IS_B ? 768 : 512;
    bf16x8 qf[2][DQK / 32];
#pragma unroll
    for (int qt = 0; qt < 2; ++qt) { const bf16_t* qp = Q + (size_t)(q_tok0 + wave * 32 + qt * 16 + qi) * ldq + h * DQK + quad * 8;
#pragma unroll
        for (int kk = 0; kk < DQK / 32; ++kk) qf[qt][kk] = *(const bf16x8*)(qp + 32 * kk); }
    float m_run[2], l_run[2];
#pragma unroll
    for (int qt = 0; qt < 2; ++qt) { if (IS_B) { m_run[qt] = -1e30f; l_run[qt] = 0.f; } else { m_run[qt] = p->a_sink[li * 8 + h] * LOG2E; l_run[qt] = (quad == 0) ? 1.f : 0.f; } }
    f32x4 o[2][4];
#pragma unroll
    for (int qt = 0; qt < 2; ++qt)
#pragma unroll
        for (int d = 0; d < 4; ++d) o[qt][d] = (f32x4){0.f, 0.f, 0.f, 0.f};
    const int kvh = h >> 2;
    const bf16_t* KN = (const bf16_t*)(scr + SCR_KN); const bf16_t* KPE = (const bf16_t*)(scr + SCR_KPE); const bf16_t* KA = (const bf16_t*)(scr + SCR_KA);
    const bf16_t* VT = (const bf16_t*)(scr + (IS_B ? SCR_VT : SCR_VAT));
    constexpr int BUF = 64 * KSTR + 64 * VSTR;
    const int r0 = IS_B ? tid / 12 : tid >> 3, c0 = IS_B ? tid % 12 : tid & 7;
    const int r1 = (tid + 512) / 12, c1 = (tid + 512) % 12;
    const int vd = tid >> 3, vc = tid & 7;
    const bf16_t* vrow = VT + (size_t)((IS_B ? h : kvh) * 64 + vd) * KR + vc * 8;
    u32x4 kreg0, kreg1 = (u32x4){0u, 0u, 0u, 0u}, vreg;
#define ATT_KR0(it_) ((!IS_B && lat && (it_) >= 4) ? kbase + 256 + lo + 64 * ((it_) - 4) : kbase + 64 * (it_))
#define ATT_LOAD(it_) do { const int kr_ = ATT_KR0(it_); \
        if (IS_B) { kreg0 = c0 < 8 ? *(const u32x4*)(KN + (size_t)(kr_ + r0) * 512 + h * 64 + c0 * 8) : *(const u32x4*)(KPE + (size_t)(kr_ + r0) * 32 + (c0 - 8) * 8); \
            if (tid < 256) kreg1 = c1 < 8 ? *(const u32x4*)(KN + (size_t)(kr_ + r1) * 512 + h * 64 + c1 * 8) : *(const u32x4*)(KPE + (size_t)(kr_ + r1) * 32 + (c1 - 8) * 8); } \
        else kreg0 = *(const u32x4*)(KA + (size_t)(kr_ + r0) * 128 + kvh * 64 + c0 * 8); \
        vreg = *(const u32x4*)(vrow + kr_); } while (0)
#define ATT_STORE(buf_) do { LAS bf16_t* kb_ = (LAS bf16_t*)lds + (buf_) * BUF; \
        *(LAS u32x4*)(kb_ + r0 * KSTR + c0 * 8) = kreg0; \
        if (IS_B && tid < 256) *(LAS u32x4*)(kb_ + r1 * KSTR + c1 * 8) = kreg1; \
        *(LAS u32x4*)(kb_ + 64 * KSTR + vd * VSTR + vc * 8) = vreg; } while (0)
    __syncthreads();
    ATT_LOAD(0); ATT_STORE(0);
    if (ntiles > 1) ATT_LOAD(1);
    __syncthreads();
    const int qa = qblk * 256 + wave * 32;
    for (int it = 0; it < ntiles; ++it) {
        int kpos0 = 0; bool masked = false;
        if (!IS_B && lat && it >= 4) { kpos0 = lo + 64 * (it - 4); masked = true; }
        if (it + 1 < ntiles) ATT_STORE((it + 1) & 1);
        if (it + 2 < ntiles) ATT_LOAD(it + 2);
        const bool need = !masked || (kpos0 <= qa + 31 + 128 && kpos0 + 63 >= qa - 128);
        if (need) {
            LAS bf16_t* Ks = (LAS bf16_t*)lds + (it & 1) * BUF; LAS bf16_t* Vs = Ks + 64 * KSTR;
            f32x4 s[2][4];
            __builtin_amdgcn_s_setprio(1);
#pragma unroll
            for (int kt = 0; kt < 4; ++kt) {
#pragma unroll
                for (int qt = 0; qt < 2; ++qt) s[qt][kt] = (f32x4){0.f, 0.f, 0.f, 0.f};
#pragma unroll
                for (int kk = 0; kk < DQK / 32; ++kk) { const bf16x8 a = *(const LAS bf16x8*)(Ks + (kt * 16 + qi) * KSTR + quad * 8 + 32 * kk);
#pragma unroll
                    for (int qt = 0; qt < 2; ++qt) s[qt][kt] = __builtin_amdgcn_mfma_f32_16x16x32_bf16(a, qf[qt][kk], s[qt][kt], 0, 0, 0); } }
            __builtin_amdgcn_s_setprio(0);
            u32x4 pbu[2][2];
#pragma unroll
            for (int qt = 0; qt < 2; ++qt) {
                if (masked) { const int qpos = qa + qt * 16 + qi;
#pragma unroll
                    for (int kt = 0; kt < 4; ++kt)
#pragma unroll
                        for (int j = 0; j < 4; ++j) { const int dd = qpos - (kpos0 + kt * 16 + quad * 4 + j); if (dd > 128 || dd < -128) s[qt][kt][j] = -1e30f; } }
                float tmax = s[qt][0][0];
#pragma unroll
                for (int kt = 0; kt < 4; ++kt)
#pragma unroll
                    for (int j = 0; j < 4; ++j) tmax = fmaxf(tmax, s[qt][kt][j]);
                tmax = xor16_max(tmax); tmax = xor32_max(tmax);
                const float m_new = fmaxf(m_run[qt], tmax), alpha = __builtin_amdgcn_exp2f(m_run[qt] - m_new); m_run[qt] = m_new;
                float psum = 0.f;
#pragma unroll
                for (int kt = 0; kt < 4; ++kt)
#pragma unroll
                    for (int j = 0; j < 4; ++j) { const float e = __builtin_amdgcn_exp2f(s[qt][kt][j] - m_new); s[qt][kt][j] = e; psum += e; }
                l_run[qt] = l_run[qt] * alpha + psum;
#pragma unroll
                for (int d = 0; d < 4; ++d) o[qt][d] = o[qt][d] * alpha;
#pragma unroll
                for (int ks = 0; ks < 2; ++ks) { pbu[qt][ks].x = cvt_pk_bf16(s[qt][2 * ks][0], s[qt][2 * ks][1]); pbu[qt][ks].y = cvt_pk_bf16(s[qt][2 * ks][2], s[qt][2 * ks][3]);
                    pbu[qt][ks].z = cvt_pk_bf16(s[qt][2 * ks + 1][0], s[qt][2 * ks + 1][1]); pbu[qt][ks].w = cvt_pk_bf16(s[qt][2 * ks + 1][2], s[qt][2 * ks + 1][3]); }
            }
            __builtin_amdgcn_s_setprio(1);
#pragma unroll
            for (int ks = 0; ks < 2; ++ks)
#pragma unroll
                for (int d = 0; d < 4; ++d) {
                    const u32x2 vlo = *(const LAS u32x2*)(Vs + (d * 16 + qi) * VSTR + (2 * ks) * 16 + quad * 4);
                    const u32x2 vhi = *(const LAS u32x2*)(Vs + (d * 16 + qi) * VSTR + (2 * ks + 1) * 16 + quad * 4);
                    u32x4 au; au.x = vlo.x; au.y = vlo.y; au.z = vhi.x; au.w = vhi.y;
                    const bf16x8 av = __builtin_bit_cast(bf16x8, au);
#pragma unroll
                    for (int qt = 0; qt < 2; ++qt) o[qt][d] = __builtin_amdgcn_mfma_f32_16x16x32_bf16(av, __builtin_bit_cast(bf16x8, pbu[qt][ks]), o[qt][d], 0, 0, 0);
                }
            __builtin_amdgcn_s_setprio(0);
        }
        __syncthreads();
    }
#undef ATT_KR0
#undef ATT_LOAD
#undef ATT_STORE
#pragma unroll
    for (int qt = 0; qt < 2; ++qt) {
        const float lt = xor32_sum(xor16_sum(l_run[qt]));
        const float inv = 1.f / lt;
        bf16_t* op = (bf16_t*)(scr + SCR_AO) + (size_t)(q_tok0 + wave * 32 + qt * 16 + qi) * 1024 + (IS_B ? 512 : 0) + h * 64 + quad * 4;
#pragma unroll
        for (int d = 0; d < 4; ++d) { u32x2 ov; ov.x = cvt_pk_bf16(o[qt][d][0] * inv, o[qt][d][1] * inv); ov.y = cvt_pk_bf16(o[qt][d][2] * inv, o[qt][d][3] * inv); *(u32x2*)(op + d * 16) = ov; }
    }
}
__device__ __forceinline__ void phase_attn(KP p, LAS unsigned char* lds, int li) {
    for (int it = blockIdx.x; it < 1280; it += gridDim.x) {
        bool isB, lat; int b, h, qb;
        if (it < 1024) { lat = true; isB = it < 512; const int x = it & 511; b = x >> 6; h = (x >> 3) & 7; qb = x & 7; }
        else { lat = false; const int x = (it - 1024) & 127; isB = it < 1152; b = x >> 3; h = x & 7; qb = 0; }
        if (isB) attn_item<true>(lds, p, lat, b, h, qb, li); else attn_item<false>(lds, p, lat, b, h, qb, li);
    }
}

enum { E_F32 = 0, E_BF16 = 1, E_SWIGLU = 2, E_RESID = 3, E_QB = 4, E_PT = 5 };
struct GCall { int type; pg8::Gemm g; void* o; int ldc; float scale; size_t zoff; int pm_stride; const float* gate; float gs; int rot; int xlf; };

__device__ __forceinline__ void run_gemm(LAS unsigned char* lds, KP p, const GCall& c) {
    pg8::Order S; S.init(c.g.M, c.g.N, c.g.nz, gridDim.x, (int)((blockIdx.x + c.rot) % gridDim.x));
#ifndef TMASK
#define TMASK 62
#endif
    switch (c.type) {
    case E_F32: if (TMASK & 1) { pg8::EpiStoreF32 e{(float*)c.o, c.ldc}; pg8::gemm_phase(lds, c.g, S, e); break; }
    case E_BF16: if (TMASK & 2) { pg8::EpiStoreBf16 e{(bf16_t*)c.o, c.ldc, c.scale, c.zoff, c.pm_stride}; pg8::gemm_phase(lds, c.g, S, e);
        if (c.xlf >= 0) {
            if (gridDim.x == 256) { if (blockIdx.x >= 128) transpose_range(p, lds, c.xlf * LF_TILES, (c.xlf + 1) * LF_TILES, (int)blockIdx.x - 128, 128); }
            else transpose_range(p, lds, c.xlf * LF_TILES, (c.xlf + 1) * LF_TILES, (int)blockIdx.x, (int)gridDim.x);
        }
        break; }
    case E_SWIGLU: if (TMASK & 4) { pg8::EpiSwiGLU e{(bf16_t*)c.o}; pg8::gemm_phase(lds, c.g, S, e); break; }
    case E_QB: if (TMASK & 16) { pg8::EpiQb e{(bf16_t*)c.o}; pg8::gemm_phase(lds, c.g, S, e); break; }
    default: if (TMASK & 32) { pg8::EpiPt e{(bf16_t*)(p->ws + OFF_SCR + SCR_PTL), (bf16_t*)(p->ws + OFF_SCR + SCR_PTC)}; pg8::gemm_phase(lds, c.g, S, e); break; }
    }
}

__device__ __forceinline__ pg8::Gemm mk_gemm(const void* A, const void* Bt, int M, int N, int K, int nz = 1, size_t zA = 0, size_t zB = 0) {
    pg8::Gemm g; g.A = (const bf16_t*)A; g.Bt = (const bf16_t*)Bt; g.M = M; g.N = N; g.K = K; g.ld = K; g.nz = nz; g.zA = zA; g.zB = zB; return g;
}

__device__ __forceinline__ bool build_call(KP p, int ph, int k, GCall& c) {
    unsigned char* ws = p->ws; unsigned char* scr = ws + OFF_SCR;
    const float* mods = (const float*)(ws + OFF_MODS);
#define MODP(l, idx) (mods + (size_t)(l) * 9 * 9216 + (idx) * 1024)
    c.type = E_BF16; c.o = nullptr; c.ldc = 0; c.scale = 1.f; c.zoff = 0; c.pm_stride = 256; c.gate = nullptr; c.gs = 0.f; c.rot = 0; c.xlf = -1;
    c.g = mk_gemm(nullptr, nullptr, 0, 0, 256);
    if (ph == 0 || ph == 2) return false;
    if (ph == 1) {
        if (k >= 2) return false;
        const int i = k;
        c.g = mk_gemm(ws + OFF_CST, ws + OFF_WFING + (size_t)i * 4 * 1024 * 256 * 2, 512, 1024, 256, 4, 0, (size_t)1024 * 256 * 2);
        c.o = ws + OFF_WFOLD + (size_t)i * 2048 * 1024 * 2; c.ldc = 1024; c.zoff = (size_t)256 * 1024; c.pm_stride = 1024; c.rot = i * 32; return true;
    }
    int q = ph - 3, l;
    if (q < 12) l = 0; else if (q < 22) { l = 1; q -= 12; } else if (q < 34) { l = 2; q -= 22; } else { l = 3; q -= 34; }
    const int i = l >> 1; const bool even = (l & 1) == 0;
    int code;
    if (q < 3) code = q; else { const int nm = even ? 5 : 3; code = (q < 3 + nm) ? 10 + (q - 3) : 100 + (q - 3 - nm); }
    if (code == 0 || code == 101) { if (k) return false; const int f = code == 0 ? 0 : 1; c.type = E_SWIGLU;
        c.g = mk_gemm(ws + OFF_HMOD, ws + OFF_W1T + (size_t)(l * 2 + f) * 5632 * 1024 * 2, T, 5632, 1024); c.o = scr + SCR_HFF; return true; }
    if (code == 1 || code == 102) { if (k) return false; const int f = code == 1 ? 0 : 1; c.type = E_BF16; c.o = scr + SCR_Z1; c.ldc = 1024; c.zoff = (size_t)T * 1024; c.scale = 0.5f;
        c.g = mk_gemm(scr + SCR_HFF, ws + OFF_W2T + (size_t)(l * 2 + f) * 1024 * 2816 * 2, T, 1024, 1408, 2, 1408 * 2, 1408 * 2); c.g.ld = 2816; c.xlf = l < 3 ? 2 * (l + 1) + f : -1; return true; }
    if (code == 2 || code >= 100) return false;
    if (even) {
        if (code == 10) { if (k) return false;
            c.g = mk_gemm(ws + OFF_HMOD, ws + OFF_WINT + (size_t)i * 1536 * 1024 * 2, T, 1536, 1024); c.o = scr + SCR_PROJ; c.ldc = 1536; return true; }
        if (code == 12) {
            if (k == 0) { c.type = E_QB; c.g = mk_gemm(scr + SCR_CQN, ws + OFF_WUQT + (size_t)i * 768 * 384 * 2, T, 768, 384); c.o = scr + SCR_QB; return true; }
            if (k == 1) { c.g = mk_gemm(scr + SCR_CKVN, ws + OFF_WUKT + (size_t)i * 512 * 256 * 2, KR, 512, 256); c.o = scr + SCR_KN; c.ldc = 512; c.rot = 240; return true; }
            if (k == 2) { c.g = mk_gemm(ws + OFF_WUVT + (size_t)i * 512 * 256 * 2, scr + SCR_CKVN, 512, KR, 256); c.o = scr + SCR_VT; c.ldc = KR; c.rot = 160; return true; }
            return false;
        }
        if (code == 14) { if (k) return false; c.type = E_BF16; c.o = scr + SCR_Z1; c.ldc = 1024; c.zoff = (size_t)T * 1024;
            c.g = mk_gemm(scr + SCR_AO, ws + OFF_WOUTT + (size_t)i * 1024 * 1024 * 2, T, 1024, 512, 2, 512 * 2, 512 * 2); c.g.ld = 1024; return true; }
        return false;
    }
    if (code == 10) { if (k) return false; c.type = E_PT; c.g = mk_gemm(ws + OFF_WFOLD + (size_t)i * 2048 * 1024 * 2, ws + OFF_HMOD, 2048, T, 1024); return true; }
    if (code == 11) {
        if (k == 0) { c.g = mk_gemm(ws + OFF_TWLAT, scr + SCR_PTL, 2048, 1024, 4096, 8, 0, (size_t)1024 * 4096 * 2);
            c.o = scr + SCR_FM + (size_t)TC * 1024 * 2; c.ldc = 1024; c.scale = 0.001381067932004975f; c.zoff = (size_t)2048 * 1024; return true; }
        if (k == 1) { c.g = mk_gemm(ws + OFF_TWCTX, scr + SCR_PTC, 256, 1024, 512, 16, 0, (size_t)1024 * 512 * 2);
            c.o = scr + SCR_FM; c.ldc = 1024; c.scale = 0.00390625f; c.zoff = (size_t)256 * 1024; return true; }
        return false;
    }
    if (code == 12) { if (k) return false; c.type = E_BF16; c.o = scr + SCR_Z1; c.ldc = 1024; c.zoff = (size_t)T * 1024;
        c.g = mk_gemm(scr + SCR_FM, ws + OFF_WFOUTT + (size_t)i * 1024 * 1024 * 2, T, 1024, 512, 2, 512 * 2, 512 * 2); c.g.ld = 1024; return true; }
    return false;
}
__device__ __forceinline__ void run_simple(KP p, LAS unsigned char* lds, int ph) {
    const float* mods = (const float*)(p->ws + OFF_MODS);
#ifndef SMASK
#define SMASK 31
#endif
    if (ph == 0) { if (SMASK & 1) phase_p0(p, lds); return; }
    if (ph == 1) { if (SMASK & 2) phase_p1_mods(p); return; }
    int q = ph - 3, l = 0; bool first = ph == 2;
    if (!first) { if (q < 12) l = 0; else if (q < 22) { l = 1; q -= 12; } else if (q < 34) { l = 2; q -= 22; } else { l = 3; q -= 34; } }
    const int i = l >> 1; const bool even = (l & 1) == 0;
    int code = 0;
    if (!first) { if (q < 3) code = q; else { const int nm = even ? 5 : 3; code = (q < 3 + nm) ? 10 + (q - 3) : 100 + (q - 3 - nm); } }
    int lnk = -1, ml = l, ms = 0; bool wh = true;
    if (first) { lnk = 0; ml = 0; ms = 0; }
    else if (code == 2) { lnk = 0; ms = 3; }
    else if (code == 100) { lnk = 1; ms = 6; }
    else if (code == 103) { lnk = 2; ml = l < 3 ? l + 1 : 3; ms = 0; wh = l < 3; }
    if (lnk >= 0) {
        const float* g_ = p->ln_g + (l * 3 + lnk) * 1024; const float* b_ = p->ln_b + (l * 3 + lnk) * 1024;
        const float* sh = MODP(ml, ms); const float* sc = MODP(ml, ms + 1); const float* gt = MODP(l, 2 + 3 * lnk);
        if (SMASK & 4) { if (first) phase_ln<false>(p, g_, b_, gt, sh, sc, true); else phase_ln<true>(p, g_, b_, gt, sh, sc, wh); }
        return;
    }
    if (even && code == 11) { if (SMASK & 8) phase_postproj(p, i); return; }
    if (even && code == 13) { if (SMASK & 16) phase_attn(p, lds, i); return; }
#undef MODP
}
__device__ __forceinline__ void run_phase(KP p, LAS unsigned char* lds, int ph) {
    run_simple(p, lds, ph);
    for (int k = 0; k < 3; ++k) { GCall c; if (!build_call(p, ph, k, c)) break; run_gemm(lds, p, c); }
}

#ifndef REPEAT_MASK
#define REPEAT_MASK 0
#endif
#define XB_TMO      128
#define XB_XCNT(j)  (256  + 64 * (j))
#define XB_XSUB(j)  (1280 + 64 * (j))
#define XB_XGEN(j)  (2304 + 64 * (j))
#define XB_TOP      3328
#define XB_TOPGEN   3392
#define XCD_BAR_WORDS 3456
#define XB_SPIN_CAP (1u << 18)

__device__ __forceinline__ unsigned xb_ld(unsigned* p)              { return __hip_atomic_load(p, __ATOMIC_RELAXED, __HIP_MEMORY_SCOPE_AGENT); }
__device__ __forceinline__ unsigned xb_add(unsigned* p, unsigned v) { return __hip_atomic_fetch_add(p, v, __ATOMIC_RELAXED, __HIP_MEMORY_SCOPE_AGENT); }
__device__ __forceinline__ unsigned xb_xcc_id() { return (unsigned)__builtin_amdgcn_s_getreg((3 << 11) | 20) & 0xFu; }
#define XB_SPIN(cond, bar) do { unsigned _sp = 0; while (cond) { __builtin_amdgcn_s_sleep(1); \
    if ((++_sp & 255u) == 0u) { if (xb_ld(&(bar)[XB_TMO])) break; if (_sp > XB_SPIN_CAP) { atomicAdd(&(bar)[XB_TMO], 1u); break; } } } } while (0)

struct XcdBarrier {
    unsigned* bar; unsigned x;
    volatile LAS unsigned* st;
};

__device__ __forceinline__ XcdBarrier xcd_barrier_post(unsigned* bar, volatile LAS unsigned* st) {
    XcdBarrier b; b.bar = bar; b.x = xb_xcc_id(); b.st = st;
    if (threadIdx.x == 0) (void)xb_add(&bar[XB_XCNT(b.x)], 1u);
    return b;
}
__device__ __forceinline__ void xcd_barrier_complete(unsigned* bar, unsigned x, unsigned& nloc, unsigned& nx) {
    const unsigned G = gridDim.x * gridDim.y * gridDim.z;
    unsigned sum, cnt, mine, sp = 0u;
    for (;;) {
        sum = 0u; cnt = 0u; mine = 0u;
#pragma unroll
        for (unsigned j = 0; j < 16; ++j) { const unsigned c = xb_ld(&bar[XB_XCNT(j)]); sum += c; cnt += (c > 0u) ? 1u : 0u; mine = (j == x) ? c : mine; }
        if (sum == G) break;
        __builtin_amdgcn_s_sleep(1);
        if ((++sp & 255u) == 0u) { if (xb_ld(&bar[XB_TMO])) break; if (sp > XB_SPIN_CAP) { atomicAdd(&bar[XB_TMO], 1u); break; } }
    }
    nloc = mine > 0u ? mine : 1u; nx = cnt > 0u ? cnt : 1u;
}

__device__ __forceinline__ void xcd_barrier(const XcdBarrier& b) {
    asm volatile("s_waitcnt vmcnt(0)" ::: "memory");
    __syncthreads();
    if (threadIdx.x == 0) {
        unsigned* bar = b.bar;
        __builtin_amdgcn_s_waitcnt(0);
        unsigned nloc = b.st[0], nx = b.st[1];
        if (nloc == 0u) { xcd_barrier_complete(bar, b.x, nloc, nx); b.st[0] = nloc; b.st[1] = nx; }
        const unsigned old = xb_add(&bar[XB_XSUB(b.x)], 1u);
        const unsigned gen = old / nloc;
        if (old + 1u == (gen + 1u) * nloc) {
            __builtin_amdgcn_fence(__ATOMIC_RELEASE, "agent");
            asm volatile("s_waitcnt vmcnt(0)" ::: "memory");
            const unsigned og = xb_add(&bar[XB_TOP], 1u);
            const unsigned tg = og / nx;
            if (og + 1u == (tg + 1u) * nx) xb_add(&bar[XB_TOPGEN], 1u);
            else XB_SPIN(xb_ld(&bar[XB_TOPGEN]) == tg, bar);
            __builtin_amdgcn_fence(__ATOMIC_ACQUIRE, "agent");
            xb_add(&bar[XB_XGEN(b.x)], 1u);
            asm volatile("s_waitcnt vmcnt(0)" ::: "memory");
        } else {
            XB_SPIN(xb_ld(&bar[XB_XGEN(b.x)]) == gen, bar);
            __builtin_amdgcn_fence(__ATOMIC_ACQUIRE, "agent");
            asm volatile("s_waitcnt vmcnt(0)" ::: "memory");
        }
    }
    __syncthreads();
}

__device__ __forceinline__ int phase_class(int ph) {
    if (ph < 3) return ph;
    int q = ph - 3, l;
    if (q < 12) l = 0; else if (q < 22) { l = 1; q -= 12; } else if (q < 34) { l = 2; q -= 22; } else { l = 3; q -= 34; }
    const bool even = (l & 1) == 0; const int nm = even ? 5 : 3;
    if (q == 0) return 3; if (q == 1) return 4; if (q == 2) return 5;
    if (q < 3 + nm) return even ? 6 + (q - 3) : 11 + (q - 3);
    const int r = q - 3 - nm;
    return r == 0 ? 5 : (r == 1 ? 3 : (r == 2 ? 4 : 5));
}
__global__ void __launch_bounds__(512, 2) mega_kernel(Params pbyval) {
    extern __shared__ __attribute__((aligned(16))) unsigned char smem[];
    LAS unsigned char* lds = (LAS unsigned char*)smem;
    cg::grid_group grid = cg::this_grid();
    unsigned long long ka = (unsigned long long)__builtin_amdgcn_kernarg_segment_ptr();
    asm volatile("" : "+s"(ka));
    const int ph_lo = ((KP)ka)->ph_lo, ph_hi = ((KP)ka)->ph_hi;
    volatile LAS unsigned* xst = (volatile LAS unsigned*)(lds + 131072);
    if (threadIdx.x == 0) { xst[0] = 0u; xst[1] = 0u; }
    __syncthreads();
    const XcdBarrier xb = xcd_barrier_post((unsigned*)(((KP)ka)->ws + OFF_BAR), xst);
    for (int ph = ph_lo; ph < ph_hi; ++ph) {
#if REPEAT_MASK
        int reps = ((REPEAT_MASK >> phase_class(ph)) & 1) ? 2 : 1;
        for (int r = 0; r < reps; ++r) {
            asm volatile("" : "+s"(ka));
            if (r > 0) xcd_barrier(xb);
            if (!(r > 0 && (REPEAT_MASK >> 14) & 1)) run_phase((KP)ka, lds, ph);
        }
#else
        asm volatile("" : "+s"(ka));
        run_phase((KP)ka, lds, ph);
#endif
        if (ph + 1 < ph_hi) { if (ph_hi > 100000) grid.sync(); xcd_barrier(xb); }
    }
}

static void add_job(Params& p, int& nj, int& tiles, const float* src, bf16_t* dst, int K, int lds, int ncols, int nvalid, int sblk, int sstride, int soff, int dblk, int dstride, int doff) {
    TJob& J = p.jobs[nj++]; J.src = src; J.dst = dst; J.K = K; J.lds = lds; J.ncols = ncols; J.nvalid = nvalid; J.sblk = sblk; J.sstride = sstride; J.soff = soff;
    J.dblk = dblk; J.dstride = dstride; J.doff = doff; J.tile0 = tiles; J.pad = 0; tiles += (K / 64) * (ncols / 64);
}

extern "C" void kernel_launch(void* const* d_in, const int* in_sizes, int n_in, void* d_out, int out_size, void* d_ws, size_t ws_size, hipStream_t stream) {
    static int grid = 0;
    if (grid == 0) {
        if (n_in != 24 || ws_size < WS_NEED) { fprintf(stderr, "kernel_launch: need 24 inputs and %zu bytes of workspace; got %d, %zu\n", (size_t)WS_NEED, n_in, ws_size); grid = -1; return; }
        int dev = 0, cus = 0, per_cu = 0;
        hipGetDevice(&dev); hipDeviceGetAttribute(&cus, hipDeviceAttributeMultiprocessorCount, dev);
        if (hipFuncSetAttribute((const void*)mega_kernel, hipFuncAttributeMaxDynamicSharedMemorySize, LDS_BYTES) != hipSuccess) { fprintf(stderr, "hipFuncSetAttribute failed\n"); grid = -1; return; }
        hipOccupancyMaxActiveBlocksPerMultiprocessor(&per_cu, (const void*)mega_kernel, 512, LDS_BYTES);
        if (per_cu < 1) { fprintf(stderr, "occupancy query says %d blocks per CU\n", per_cu); per_cu = 1; }
        (void)hipGetLastError();
        grid = cus * 1;
    }
    if (grid < 0) return;
    Params p; memset(&p, 0, sizeof(p));
    const float** ip = (const float**)&p.x_prompt;
    for (int i = 0; i < 24; ++i) ip[i] = (const float*)d_in[i];
    p.out = (float*)d_out; p.ws = (unsigned char*)d_ws;
    unsigned char* ws = (unsigned char*)d_ws;
    int nj = 0, tiles = 0; const int BIG = 1 << 30;
    for (int lf = 0; lf < 8; ++lf) {
        add_job(p, nj, tiles, p.ffn_w_gate + (size_t)lf * 1024 * 2816, (bf16_t*)(ws + OFF_W1T) + (size_t)lf * 5632 * 1024, 1024, 2816, 2816, 2816, BIG, 0, 0, 128, 256, 0);
        add_job(p, nj, tiles, p.ffn_w_up + (size_t)lf * 1024 * 2816, (bf16_t*)(ws + OFF_W1T) + (size_t)lf * 5632 * 1024, 1024, 2816, 2816, 2816, BIG, 0, 0, 128, 256, 128);
        add_job(p, nj, tiles, p.ffn_w_down + (size_t)lf * 2816 * 1024, (bf16_t*)(ws + OFF_W2T) + (size_t)lf * 1024 * 2816, 2816, 1024, 1024, 1024, BIG, 0, 0, BIG, 0, 0);
    }
    for (int i = 0; i < 2; ++i) {
        add_job(p, nj, tiles, p.ab_w_in + (size_t)i * 1024 * 1440, (bf16_t*)(ws + OFF_WINT) + (size_t)i * 1536 * 1024, 1024, 1440, 1536, 1440, BIG, 0, 0, BIG, 0, 0);
        add_job(p, nj, tiles, p.ab_w_out + (size_t)i * 1024 * 1024, (bf16_t*)(ws + OFF_WOUTT) + (size_t)i * 1024 * 1024, 1024, 1024, 1024, 1024, BIG, 0, 0, BIG, 0, 0);
        add_job(p, nj, tiles, p.b_w_uq + (size_t)i * 384 * 768, (bf16_t*)(ws + OFF_WUQT) + (size_t)i * 768 * 384, 384, 768, 768, 768, BIG, 0, 0, BIG, 0, 0);
        add_job(p, nj, tiles, p.b_w_ukv + (size_t)i * 256 * 1024, (bf16_t*)(ws + OFF_WUKT) + (size_t)i * 512 * 256, 256, 1024, 512, 512, 64, 128, 0, BIG, 0, 0);
        add_job(p, nj, tiles, p.b_w_ukv + (size_t)i * 256 * 1024, (bf16_t*)(ws + OFF_WUVT) + (size_t)i * 512 * 256, 256, 1024, 512, 512, 64, 128, 64, BIG, 0, 0);
        add_job(p, nj, tiles, p.f_w_out + (size_t)i * 1024 * 1024, (bf16_t*)(ws + OFF_WFOUTT) + (size_t)i * 1024 * 1024, 1024, 1024, 1024, 1024, BIG, 0, 0, BIG, 0, 0);
    }
    p.ntiles_total = tiles;
    if (p.jobs[24].tile0 != 8 * LF_TILES) { fprintf(stderr, "kernel_launch: job table does not match LF_TILES\n"); return; }
#if SINGLE_LAUNCH
    (void)hipMemsetAsync(ws + OFF_BAR, 0, 16384, stream);
    p.ph_lo = 0; p.ph_hi = NPH;
    void* args[] = {&p};
    hipError_t e = hipLaunchCooperativeKernel((const void*)mega_kernel, dim3(grid), dim3(512), args, LDS_BYTES, stream);
    if (e != hipSuccess) fprintf(stderr, "cooperative launch failed: %s (grid %d)\n", hipGetErrorString(e), grid);
#else
    for (int ph = 0; ph < NPH; ++ph) { p.ph_lo = ph; p.ph_hi = ph + 1; hipLaunchKernelGGL(mega_kernel, dim3(grid), dim3(512), LDS_BYTES, stream, p); }
#endif
}
```

```cpp
#include <hip/hip_runtime.h>
#include <hip/hip_cooperative_groups.h>
#include <cstdio>
#include <cstdint>
#include <cstring>
namespace cg = cooperative_groups;


#ifndef SINGLE_LAUNCH
#define SINGLE_LAUNCH 1
#endif

#define LAS __attribute__((address_space(3)))
typedef unsigned short bf16_t;
typedef short bf16x8 __attribute__((ext_vector_type(8)));
typedef float f32x4 __attribute__((ext_vector_type(4)));
typedef unsigned u32x4 __attribute__((ext_vector_type(4)));
typedef unsigned u32x2 __attribute__((ext_vector_type(2)));
typedef _Float16 f16x4_t __attribute__((ext_vector_type(4)));

constexpr int D = 1024, FF = 2816, TC = 4096, TL = 16384, T = TC + TL, KR = TC + 8 * 2304;
constexpr int NPH = 47;
constexpr float ALPHA = 1.6817928305074290f;
constexpr float LOG2E = 1.4426950408889634f;
constexpr float QA_SCALE = 0.125f * LOG2E;
constexpr float QB_SCALE = 0.10206207261596575f * LOG2E;
constexpr float INV2PI = 0.15915494309189535f;
constexpr float LOG2_10000 = 13.287712379549449f;

constexpr size_t al256(size_t x) { return (x + 255) & ~(size_t)255; }
constexpr size_t OFF_W1T = 0;
constexpr size_t OFF_W2T = OFF_W1T + (size_t)8 * 5632 * 1024 * 2;
constexpr size_t OFF_WINT = OFF_W2T + (size_t)8 * 1024 * 2816 * 2;
constexpr size_t OFF_WOUTT = OFF_WINT + (size_t)2 * 1536 * 1024 * 2;
constexpr size_t OFF_WUQT = OFF_WOUTT + (size_t)2 * 1024 * 1024 * 2;
constexpr size_t OFF_WUKT = OFF_WUQT + (size_t)2 * 768 * 384 * 2;
constexpr size_t OFF_WUVT = OFF_WUKT + (size_t)2 * 512 * 256 * 2;
constexpr size_t OFF_WFING = OFF_WUVT + (size_t)2 * 512 * 256 * 2;
constexpr size_t OFF_CST = OFF_WFING + (size_t)2 * 4 * 1024 * 256 * 2;
constexpr size_t OFF_WFOLD = OFF_CST + (size_t)512 * 256 * 2;
constexpr size_t OFF_WFOUTT = OFF_WFOLD + (size_t)2 * 2048 * 1024 * 2;
constexpr size_t OFF_TWLAT = OFF_WFOUTT + (size_t)2 * 1024 * 1024 * 2;
constexpr size_t OFF_TWCTX = OFF_TWLAT + (size_t)2048 * 4096 * 2;
constexpr size_t OFF_MODS = OFF_TWCTX + (size_t)256 * 512 * 2;
constexpr size_t OFF_HMOD = OFF_MODS + (size_t)4 * 9 * 9216 * 4;
constexpr size_t OFF_Z = OFF_HMOD + (size_t)T * 1024 * 2;
constexpr size_t OFF_SCR = OFF_Z + (size_t)T * 1024 * 4;
constexpr size_t SCR_HFF = 0;
constexpr size_t SCR_MODP = 0;
constexpr size_t SCR_PROJ = 0;
constexpr size_t SCR_QB = 0;
constexpr size_t SCR_KN = SCR_QB + (size_t)T * 768 * 2;
constexpr size_t SCR_VT = SCR_KN + (size_t)KR * 512 * 2;
constexpr size_t SCR_AO = SCR_VT + (size_t)512 * KR * 2;
constexpr size_t SCR_PROJ_END = (size_t)T * 1536 * 4;
static_assert(SCR_AO + (size_t)T * 1024 * 2 <= SCR_PROJ_END, "alias overflow");
constexpr size_t SCR_QA = SCR_PROJ_END;
constexpr size_t SCR_KA = SCR_QA + (size_t)T * 512 * 2;
constexpr size_t SCR_VAT = SCR_KA + (size_t)KR * 128 * 2;
constexpr size_t SCR_CQN = SCR_VAT + (size_t)128 * KR * 2;
constexpr size_t SCR_CKVN = SCR_CQN + (size_t)T * 384 * 2;
constexpr size_t SCR_KPE = SCR_CKVN + (size_t)KR * 256 * 2;
constexpr size_t SCR_EVEN_END = SCR_KPE + (size_t)KR * 32 * 2;
constexpr size_t SCR_PTL = 0;
constexpr size_t SCR_PTC = SCR_PTL + (size_t)8 * 1024 * 4096 * 2;
constexpr size_t SCR_FM = SCR_PTC + (size_t)16 * 1024 * 512 * 2;
static_assert(SCR_FM + (size_t)T * 1024 * 2 <= SCR_EVEN_END, "odd alias overflow");
static_assert((size_t)T * 2816 * 2 <= SCR_EVEN_END, "hff alias overflow");
constexpr size_t SCR_Z1 = SCR_PROJ_END;
constexpr size_t OFF_BAR = OFF_SCR + SCR_Z1 + (size_t)T * 1024 * 4;
constexpr size_t WS_NEED = OFF_BAR + 16384;
constexpr size_t O_AK = (size_t)T * 1024, O_AV = O_AK + 16 * 2 * 256 * 128, O_CKV = O_AV + 16 * 2 * 256 * 128, O_KPE = O_CKV + 16 * 2 * 256 * 256;

constexpr int LDS_BYTES = 131072 + 16;

struct TJob { const float* src; bf16_t* dst; int K, lds, ncols, nvalid, sblk, sstride, soff, dblk, dstride, doff, tile0, pad; };
constexpr int NJOBS = 36;

struct Params {
    const float *x_prompt, *x_sample, *cache_a_k, *cache_a_v, *cache_b_ckv, *cache_b_kpe, *c, *c_ctx, *w_ada, *b_ada, *ln_g, *ln_b,
        *ffn_w_gate, *ffn_w_up, *ffn_w_down, *ab_w_in, *ab_w_out, *a_sink, *b_g_cq, *b_w_uq, *b_g_ckv, *b_w_ukv, *f_w_in, *f_w_out;
    float* out; unsigned char* ws;
    int ph_lo, ph_hi, ntiles_total, pad;
    TJob jobs[NJOBS];
};

typedef const __attribute__((address_space(4))) Params* KP;
__device__ __forceinline__ int ltid() { int t = threadIdx.x; asm volatile("" : "+v"(t)); return t; }
typedef __bf16 bf16v2_t __attribute__((ext_vector_type(2)));
typedef float f32v2_t __attribute__((ext_vector_type(2)));
__device__ __forceinline__ unsigned cvt_pk_bf16(float lo, float hi) { const f32v2_t v = {lo, hi}; const bf16v2_t b = __builtin_convertvector(v, bf16v2_t); return __builtin_bit_cast(unsigned, b); }
__device__ __forceinline__ bf16_t f2bf(float f) { return (bf16_t)(cvt_pk_bf16(f, 0.f) & 0xffffu); }
typedef unsigned u32pair __attribute__((ext_vector_type(2)));
template <int CTRL> __device__ __forceinline__ float dpp_f(float v) { return __builtin_bit_cast(float, __builtin_amdgcn_update_dpp(0, __builtin_bit_cast(int, v), CTRL, 0xf, 0xf, true)); }
#define SWAP_COMBINE(name_, insn_, expr_) __device__ __forceinline__ float name_(float v) { unsigned a = __builtin_bit_cast(unsigned, v); unsigned b = a; \
    asm volatile("s_nop 1\n\t" insn_ " %0, %1\n\ts_nop 1" : "+v"(a), "+v"(b)); const float x = __builtin_bit_cast(float, a), y = __builtin_bit_cast(float, b); return expr_; }
SWAP_COMBINE(xor16_sum, "v_permlane16_swap_b32", x + y)
SWAP_COMBINE(xor32_sum, "v_permlane32_swap_b32", x + y)
SWAP_COMBINE(xor16_max, "v_permlane16_swap_b32", fmaxf(x, y))
SWAP_COMBINE(xor32_max, "v_permlane32_swap_b32", fmaxf(x, y))
__device__ __forceinline__ float wave_sum(float v) {
    v += dpp_f<0xB1>(v);
    v += dpp_f<0x4E>(v);
    v += dpp_f<0x141>(v);
    v += dpp_f<0x140>(v);
    v = xor16_sum(v);
    return xor32_sum(v);
}
__device__ __forceinline__ float silu_f(float x) { return x * __builtin_amdgcn_rcpf(1.f + __expf(-x)); }
__device__ __forceinline__ int modrow_of(int row) { return row < TC ? 0 : 1 + ((row - TC) >> 11); }

namespace pg8 {
constexpr int BM = 256, BK = 64, HALF = 128, HTB = HALF * BK * 2, STAGE_BYTES = 8 * HTB, NXCD = 8, WGM = 8;
__device__ __forceinline__ int lds_byte(int r, int c) { const int st = (r >> 4) * 2 + (c >> 5), rr = r & 15, cc = c & 31, ob = rr * 64 + cc * 2; return st * 1024 + (ob ^ (((ob >> 9) & 1) << 5)); }
__device__ __forceinline__ void stage_rc(int b, int& R, int& C) { const int st = b / 1024, sb = b % 1024, swz = sb ^ (((sb >> 9) & 1) << 5); R = (st >> 1) * 16 + swz / 64; C = (st & 1) * 32 + (swz % 64) / 2; }
__device__ __forceinline__ int perm32(int rho) { const int n = rho >> 4, i = rho & 15; return 8 * (i >> 2) + 4 * n + (i & 3); }

struct Unit { int pm, pn, z; };
struct Gemm { const bf16_t* A; const bf16_t* Bt; int M, N, K, ld, nz; size_t zA, zB; };

struct Order {
    int nM, nN, nwg, nz, G, c;
    __device__ void init(int M, int N, int nz_, int G_, int c_) { nM = M / BM; nN = N / BM; nwg = nM * nN; nz = nz_; G = G_; c = c_; }
    __device__ bool next(int i, Unit& u) const {
        const long L = (long)i * G + c; if (L >= (long)nwg * nz) return false;
        u.z = (int)(L / nwg); int wgid = (int)(L % nwg);
        { const int q = nwg / NXCD, r = nwg % NXCD, xcd = wgid % NXCD, off = wgid / NXCD; wgid = (xcd < r ? xcd * (q + 1) : r * (q + 1) + (xcd - r) * q) + off; }
        const int nig = WGM * nN, gid = wgid / nig, fm = gid * WGM, gsz = (nM - fm) < WGM ? (nM - fm) : WGM;
        u.pm = fm + ((wgid % nig) % gsz); u.pn = (wgid % nig) / gsz; return true;
    }
};

typedef f32x4 Acc[2][2][4][2];

struct EpiStoreF32 {
    static constexpr bool PERM = false;
    float* C; int ldc;
    __device__ __forceinline__ void operator()(const Acc& acc, const Unit& u, int wr, int wc, int fr, int fq) const {
        const int row0 = u.pm * BM + wr * 64 + fr, col0 = u.pn * BM + wc * 32 + 4 * fq;
#pragma unroll
        for (int ai = 0; ai < 2; ++ai)
#pragma unroll
            for (int m = 0; m < 4; ++m) { float* rowp = C + (size_t)(row0 + ai * HALF + m * 16) * ldc + col0;
#pragma unroll
                for (int bj = 0; bj < 2; ++bj)
#pragma unroll
                    for (int n = 0; n < 2; ++n) *(f32x4*)(rowp + bj * HALF + n * 16) = acc[ai][bj][m][n]; }
    }
};
struct EpiStoreBf16 {
    static constexpr bool PERM = true;
    bf16_t* O; int ldc; float scale; size_t zoff; int pm_stride;
    __device__ __forceinline__ void operator()(const Acc& acc, const Unit& u, int wr, int wc, int fr, int fq) const {
        const int row0 = u.pm * pm_stride + wr * 64 + fr, col0 = u.pn * BM + wc * 32 + 8 * fq;
        bf16_t* base = O + (size_t)u.z * zoff;
#pragma unroll
        for (int ai = 0; ai < 2; ++ai)
#pragma unroll
            for (int m = 0; m < 4; ++m) { bf16_t* rowp = base + (size_t)(row0 + ai * HALF + m * 16) * ldc + col0;
#pragma unroll
                for (int bj = 0; bj < 2; ++bj) { const f32x4 v0 = acc[ai][bj][m][0] * scale, v1 = acc[ai][bj][m][1] * scale;
                    u32x4 o; o.x = cvt_pk_bf16(v0[0], v0[1]); o.y = cvt_pk_bf16(v0[2], v0[3]); o.z = cvt_pk_bf16(v1[0], v1[1]); o.w = cvt_pk_bf16(v1[2], v1[3]);
                    *(u32x4*)(rowp + bj * HALF) = o; } }
    }
};
struct EpiSwiGLU {
    static constexpr bool PERM = true;
    bf16_t* H;
    __device__ __forceinline__ void operator()(const Acc& acc, const Unit& u, int wr, int wc, int fr, int fq) const {
        const int row0 = u.pm * BM + wr * 64 + fr, col0 = u.pn * HALF + wc * 32 + 8 * fq;
#pragma unroll
        for (int ai = 0; ai < 2; ++ai)
#pragma unroll
            for (int m = 0; m < 4; ++m) { bf16_t* rowp = H + (size_t)(row0 + ai * HALF + m * 16) * FF + col0;
                const f32x4 g0 = acc[ai][0][m][0], g1 = acc[ai][0][m][1], u0 = acc[ai][1][m][0], u1 = acc[ai][1][m][1];
                u32x4 o; o.x = cvt_pk_bf16(silu_f(g0[0]) * u0[0], silu_f(g0[1]) * u0[1]); o.y = cvt_pk_bf16(silu_f(g0[2]) * u0[2], silu_f(g0[3]) * u0[3]);
                o.z = cvt_pk_bf16(silu_f(g1[0]) * u1[0], silu_f(g1[1]) * u1[1]); o.w = cvt_pk_bf16(silu_f(g1[2]) * u1[2], silu_f(g1[3]) * u1[3]);
                *(u32x4*)rowp = o; }
    }
};
struct EpiResid {
    static constexpr bool PERM = false;
    const float* Y; float* Z; float* Z1; const float* gate; float gs;
    __device__ __forceinline__ void operator()(const Acc& acc, const Unit& u, int wr, int wc, int fr, int fq) const {
        const int row0 = u.pm * BM + wr * 64 + fr, col0 = u.pn * BM + wc * 32 + 4 * fq;
        const int mr = u.pm < 16 ? 0 : 1 + ((u.pm - 16) >> 3);
        const float* gp = gate + (size_t)mr * 9216 + col0;
        f32x4 gv[2][2];
#pragma unroll
        for (int bj = 0; bj < 2; ++bj)
#pragma unroll
            for (int n = 0; n < 2; ++n) gv[bj][n] = *(const f32x4*)(gp + bj * HALF + n * 16) * gs;
#pragma unroll
        for (int ai = 0; ai < 2; ++ai)
#pragma unroll
            for (int m = 0; m < 4; ++m) { const size_t ro = (size_t)(row0 + ai * HALF + m * 16) * D + col0;
#pragma unroll
                for (int bj = 0; bj < 2; ++bj)
#pragma unroll
                    for (int n = 0; n < 2; ++n) {
                        if (u.z == 0) { const f32x4 y = *(const f32x4*)(Y + ro + bj * HALF + n * 16);
                            *(f32x4*)(Z + ro + bj * HALF + n * 16) = y * ALPHA + gv[bj][n] * acc[ai][bj][m][n]; }
                        else *(f32x4*)(Z1 + ro + bj * HALF + n * 16) = gv[bj][n] * acc[ai][bj][m][n]; } }
    }
};
struct EpiQb {
    static constexpr bool PERM = true;
    bf16_t* O;
    __device__ __forceinline__ void operator()(const Acc& acc, const Unit& u, int wr, int wc, int fr, int fq) const {
        const int row0 = u.pm * BM + wr * 64 + fr, col0 = u.pn * BM + wc * 32 + 8 * fq;
        const bool lat = u.pm >= 16;
#pragma unroll
        for (int bj = 0; bj < 2; ++bj) {
            const int g32 = (u.pn * BM + bj * HALF + wc * 32) >> 5;
            const bool rope = lat && (g32 % 3 == 2);
#pragma unroll
            for (int ai = 0; ai < 2; ++ai)
#pragma unroll
                for (int m = 0; m < 4; ++m) {
                    const int row = row0 + ai * HALF + m * 16;
                    f32x4 v0 = acc[ai][bj][m][0], v1 = acc[ai][bj][m][1];
                    if (rope) {
                        const int l = (row - TC) & 2047;
                        const float pos = (float)((fq < 2) ? (l >> 6) : (l & 63));
                        const float sgn = (fq & 1) ? 1.f : -1.f;
#pragma unroll
                        for (int i = 0; i < 8; ++i) {
                            const float own = i < 4 ? v0[i & 3] : v1[i & 3];
                            float oth; { unsigned a_ = __builtin_bit_cast(unsigned, own), b_ = a_;
                                asm volatile("s_nop 1\n\tv_permlane16_swap_b32 %0, %1\n\ts_nop 1" : "+v"(a_), "+v"(b_));
                                oth = (fq & 1) ? __builtin_bit_cast(float, a_) : __builtin_bit_cast(float, b_); }
                            const float rev = pos * (__builtin_amdgcn_exp2f(-(float)i * (LOG2_10000 / 8.f)) * INV2PI);
                            const float cs = __builtin_amdgcn_cosf(rev), sn = __builtin_amdgcn_sinf(rev);
                            const float r = own * cs + sgn * oth * sn;
                            if (i < 4) v0[i & 3] = r; else v1[i & 3] = r;
                        }
                    }
                    v0 = v0 * QB_SCALE; v1 = v1 * QB_SCALE;
                    u32x4 o; o.x = cvt_pk_bf16(v0[0], v0[1]); o.y = cvt_pk_bf16(v0[2], v0[3]); o.z = cvt_pk_bf16(v1[0], v1[1]); o.w = cvt_pk_bf16(v1[2], v1[3]);
                    *(u32x4*)(O + (size_t)row * 768 + col0 + bj * HALF) = o;
                }
        }
    }
};
struct EpiPt {
    static constexpr bool PERM = true;
    bf16_t* PtL; bf16_t* PtC;
    __device__ __forceinline__ void operator()(const Acc& acc, const Unit& u, int wr, int wc, int fr, int fq) const {
        const int row0 = u.pm * BM + wr * 64 + fr, col0 = u.pn * BM + wc * 32 + 8 * fq;
#pragma unroll
        for (int ai = 0; ai < 2; ++ai)
#pragma unroll
            for (int m = 0; m < 4; ++m) { const int np = row0 + ai * HALF + m * 16, s = np >> 10, n = np & 1023;
#pragma unroll
                for (int bj = 0; bj < 2; ++bj) { const int t = col0 + bj * HALF;
                    bf16_t* dst;
                    if (t < TC) { const int bc = t >> 8, l = t & 255; dst = PtC + ((size_t)(bc * 1024 + n)) * 512 + s * 256 + l; }
                    else { const int tl = t - TC, b = tl >> 11, l = tl & 2047; dst = PtL + ((size_t)(b * 1024 + n)) * 4096 + s * 2048 + l; }
                    const f32x4 v0 = acc[ai][bj][m][0], v1 = acc[ai][bj][m][1];
                    u32x4 o; o.x = cvt_pk_bf16(v0[0], v0[1]); o.y = cvt_pk_bf16(v0[2], v0[3]); o.z = cvt_pk_bf16(v1[0], v1[1]); o.w = cvt_pk_bf16(v1[2], v1[3]);
                    *(u32x4*)dst = o; } }
    }
};

template <class Epi>
__device__ __forceinline__ void gemm_phase(LAS unsigned char* lds, const Gemm g, const Order& S, const Epi& E) {
    const int tid = ltid(), wid = __builtin_amdgcn_readfirstlane(tid >> 6), lane = tid & 63, wr = wid >> 2, wc = wid & 3, fr = lane & 15, fq = lane >> 4;
    const int K = g.ld, nt = g.K / BK;
    unsigned voffA[2], voffB[2];
#pragma unroll
    for (int i = 0; i < 2; ++i) { int R, C; stage_rc(tid * 16 + i * 8192, R, C); const int Rb = Epi::PERM ? ((R & ~31) + perm32(R & 31)) : R;
        voffA[i] = (unsigned)(R * K + C) * 2u; voffB[i] = (unsigned)(Rb * K + C) * 2u; }
    const size_t kstep = (size_t)(BK * 2);
    const size_t hstep = (size_t)HALF * K * 2;
    const size_t tstep = 2 * hstep;
    const unsigned ldsw = (unsigned)wid * 1024u;
    const int aoff = lds_byte(wr * 64 + fr, fq * 8), boff = lds_byte(wc * 32 + fr, fq * 8);
#define PG8_SA(b, h) (((b) * 2 + (h)) * HTB)
#define PG8_SB(b, h) ((4 + (b) * 2 + (h)) * HTB)
#define PG8_STAGE(bufoff, gbase, voff) do { _Pragma("unroll") for (int _i = 0; _i < 2; ++_i) \
        __builtin_amdgcn_global_load_lds((const unsigned*)((const char*)(gbase) + (voff)[_i]), (LAS unsigned*)(lds + (bufoff) + ldsw + _i * 8192), 16, 0, 0); } while (0)
#define PG8_LDA(dst, b, h) do { _Pragma("unroll") for (int m = 0; m < 4; ++m) _Pragma("unroll") for (int k = 0; k < 2; ++k) dst[m][k] = *(const LAS bf16x8*)(lds + PG8_SA(b, h) + aoff + m * 2048 + k * 1024); } while (0)
#define PG8_LDB(dst, b, h) do { _Pragma("unroll") for (int n = 0; n < 2; ++n) _Pragma("unroll") for (int k = 0; k < 2; ++k) dst[n][k] = *(const LAS bf16x8*)(lds + PG8_SB(b, h) + boff + n * 2048 + k * 1024); } while (0)
#define PG8_MMA(ai, bj, At, Bt) do { __builtin_amdgcn_s_setprio(1); _Pragma("unroll") for (int m = 0; m < 4; ++m) _Pragma("unroll") for (int n = 0; n < 2; ++n) _Pragma("unroll") for (int k = 0; k < 2; ++k) \
        acc[ai][bj][m][n] = __builtin_amdgcn_mfma_f32_16x16x32_bf16(Bt[n][k], At[m][k], acc[ai][bj][m][n], 0, 0, 0); __builtin_amdgcn_s_setprio(0); } while (0)
#define PG8_WAIT_V(n) asm volatile("s_waitcnt vmcnt(" #n ")" ::: "memory")
#define PG8_WAIT_L(n) asm volatile("s_waitcnt lgkmcnt(" #n ")" ::: "memory")
#define PG8_BAR __builtin_amdgcn_s_barrier()
#define PG8_SCHED __builtin_amdgcn_sched_barrier(0)
    Unit cur, nxt; int ui = 0;
    if (!S.next(0, cur)) return;
    Acc acc;
#pragma unroll
    for (int a = 0; a < 2; ++a)
#pragma unroll
        for (int b = 0; b < 2; ++b)
#pragma unroll
            for (int m = 0; m < 4; ++m)
#pragma unroll
                for (int n = 0; n < 2; ++n) acc[a][b][m][n] = (f32x4){0.f, 0.f, 0.f, 0.f};
    bf16x8 At[4][2], B0[2][2], B1[2][2];
    const char* cA = (const char*)g.A + (size_t)cur.z * g.zA + (size_t)cur.pm * tstep; const char* cB = (const char*)g.Bt + (size_t)cur.z * g.zB + (size_t)cur.pn * tstep;
    PG8_STAGE(PG8_SB(0, 0), cB, voffB); PG8_STAGE(PG8_SB(0, 1), cB + hstep, voffB); PG8_STAGE(PG8_SA(0, 0), cA, voffA); PG8_STAGE(PG8_SA(0, 1), cA + hstep, voffA);
    if (wr == 1) PG8_BAR;
    PG8_WAIT_V(2); PG8_BAR;
    PG8_STAGE(PG8_SB(1, 0), cB + kstep, voffB); PG8_STAGE(PG8_SA(1, 0), cA + kstep, voffA); PG8_STAGE(PG8_SB(1, 1), cB + hstep + kstep, voffB);
    PG8_WAIT_V(6); PG8_BAR;
    for (;;) {
        const bool has_next = S.next(ui + 1, nxt);
        const char* nA = has_next ? (const char*)g.A + (size_t)nxt.z * g.zA + (size_t)nxt.pm * tstep : cA; const char* nB = has_next ? (const char*)g.Bt + (size_t)nxt.z * g.zB + (size_t)nxt.pn * tstep : cB;
        for (int t = 0; t < nt; t += 2) {
            const bool last = (t == nt - 2);
            const char* a1 = cA + (size_t)(t + 1) * kstep;
            const char* a2 = last ? nA : cA + (size_t)(t + 2) * kstep; const char* b2 = last ? nB : cB + (size_t)(t + 2) * kstep;
            const char* a3 = a2 + kstep; const char* b3 = b2 + kstep;
            PG8_LDB(B0, 0, 0); PG8_LDB(B1, 0, 1); PG8_SCHED; PG8_LDA(At, 0, 0); PG8_STAGE(PG8_SA(1, 1), a1 + hstep, voffA);
            PG8_WAIT_V(8); PG8_WAIT_L(0); PG8_BAR; PG8_MMA(0, 0, At, B0); PG8_MMA(0, 1, At, B1); PG8_BAR; PG8_SCHED;
            PG8_LDA(At, 0, 1); PG8_STAGE(PG8_SB(0, 0), b2, voffB); PG8_STAGE(PG8_SB(0, 1), b2 + hstep, voffB); PG8_STAGE(PG8_SA(0, 0), a2, voffA);
            PG8_WAIT_V(8); PG8_WAIT_L(0); PG8_BAR; PG8_MMA(1, 0, At, B0); PG8_MMA(1, 1, At, B1); PG8_BAR; PG8_SCHED;
            PG8_LDB(B0, 1, 0); PG8_LDB(B1, 1, 1); PG8_SCHED; PG8_LDA(At, 1, 0); PG8_STAGE(PG8_SA(0, 1), a2 + hstep, voffA);
            PG8_WAIT_V(8); PG8_WAIT_L(0); PG8_BAR; PG8_MMA(0, 0, At, B0); PG8_MMA(0, 1, At, B1); PG8_BAR; PG8_SCHED;
            PG8_LDA(At, 1, 1); PG8_STAGE(PG8_SB(1, 0), b3, voffB); PG8_STAGE(PG8_SB(1, 1), b3 + hstep, voffB); PG8_STAGE(PG8_SA(1, 0), a3, voffA);
            PG8_WAIT_V(8); PG8_WAIT_L(0); PG8_BAR; PG8_MMA(1, 0, At, B0); PG8_MMA(1, 1, At, B1); PG8_BAR; PG8_SCHED;
        }
        if (wr == 0) PG8_BAR;
        E(acc, cur, wr, wc, fr, fq);
        if (!has_next) break;
#pragma unroll
        for (int a = 0; a < 2; ++a)
#pragma unroll
            for (int b = 0; b < 2; ++b)
#pragma unroll
                for (int m = 0; m < 4; ++m)
#pragma unroll
                    for (int n = 0; n < 2; ++n) acc[a][b][m][n] = (f32x4){0.f, 0.f, 0.f, 0.f};
        cur = nxt; cA = nA; cB = nB; ++ui;
        if (wr == 1) PG8_BAR;
    }
    PG8_WAIT_V(0);
    PG8_BAR;
#undef PG8_SA
#undef PG8_SB
#undef PG8_STAGE
#undef PG8_LDA
#undef PG8_LDB
#undef PG8_MMA
#undef PG8_WAIT_V
#undef PG8_WAIT_L
#undef PG8_BAR
#undef PG8_SCHED
}
}

constexpr int LF_TILES = 3 * 16 * 44;
__device__ __forceinline__ void transpose_range(KP p, LAS unsigned char* lds, int t0, int t1, int w, int nw) {
    const int tid = ltid();
    LAS float* s = (LAS float*)lds;
    int j = 0;
    for (int tile = t0 + w; tile < t1; tile += nw) {
        while (j + 1 < NJOBS && tile >= p->jobs[j + 1].tile0) ++j;
        const __attribute__((address_space(4))) TJob& J = p->jobs[j];
        const int lt = tile - J.tile0, ntn = J.ncols >> 6, tk = lt / ntn, tn = lt % ntn, k0 = tk * 64, n0 = tn * 64;
        const int scol0 = (n0 / J.sblk) * J.sstride + (n0 % J.sblk) + J.soff;
        const int drow0 = (n0 / J.dblk) * J.dstride + (n0 % J.dblk) + J.doff;
        __syncthreads();
#pragma unroll
        for (int i = 0; i < 8; ++i) { const int idx = tid + 512 * i, kk = idx >> 6, nn = idx & 63;
            const float v = (n0 + nn < J.nvalid) ? J.src[(size_t)(k0 + kk) * J.lds + scol0 + nn] : 0.f;
            s[kk * 65 + nn] = v; }
        __syncthreads();
        { const int n = tid >> 3, ch = tid & 7; const LAS float* sp = s + (8 * ch) * 65 + n;
            u32x4 o; o.x = cvt_pk_bf16(sp[0], sp[65]); o.y = cvt_pk_bf16(sp[2 * 65], sp[3 * 65]); o.z = cvt_pk_bf16(sp[4 * 65], sp[5 * 65]); o.w = cvt_pk_bf16(sp[6 * 65], sp[7 * 65]);
            *(u32x4*)(J.dst + (size_t)(drow0 + n) * J.K + k0 + 8 * ch) = o; }
    }
}
__device__ __forceinline__ void phase_p0(KP p, LAS unsigned char* lds) {
    const int tid = ltid(), bid = blockIdx.x, G = gridDim.x;
    unsigned char* ws = p->ws;
    {
        LAS float* s = (LAS float*)lds;
        float* modp = (float*)(ws + OFF_SCR + SCR_MODP);
        for (int item = bid; item < 576; item += G) {
            const int l = item / 144, rem = item % 144, cb = rem >> 3, kc = rem & 7;
            __syncthreads();
            for (int idx = tid; idx < 9 * 128; idx += 512) { const int r = idx >> 7, k = idx & 127;
                const float x = (r == 0) ? p->c_ctx[kc * 128 + k] : p->c[(r - 1) * 1024 + kc * 128 + k];
                s[idx] = x / (1.f + __expf(-x)); }
            __syncthreads();
            const int col = cb * 512 + tid;
            const float* w = p->w_ada + ((size_t)l * 1024 + kc * 128) * 9216 + col;
            float a0 = 0.f, a1 = 0.f, a2 = 0.f, a3 = 0.f, a4 = 0.f, a5 = 0.f, a6 = 0.f, a7 = 0.f, a8 = 0.f;
            for (int kb = 0; kb < 128; kb += 32) {
                float wv[32];
#pragma unroll
                for (int k = 0; k < 32; ++k) wv[k] = w[(size_t)(kb + k) * 9216];
#pragma unroll
                for (int k = 0; k < 32; ++k) { const int kk = kb + k;
                    a0 += s[kk] * wv[k]; a1 += s[128 + kk] * wv[k]; a2 += s[256 + kk] * wv[k]; a3 += s[384 + kk] * wv[k]; a4 += s[512 + kk] * wv[k];
                    a5 += s[640 + kk] * wv[k]; a6 += s[768 + kk] * wv[k]; a7 += s[896 + kk] * wv[k]; a8 += s[1024 + kk] * wv[k]; }
            }
            float* o = modp + ((size_t)(kc * 4 + l) * 9) * 9216 + col;
            o[0] = a0; o[9216] = a1; o[2 * 9216] = a2; o[3 * 9216] = a3; o[4 * 9216] = a4; o[5 * 9216] = a5; o[6 * 9216] = a6; o[7 * 9216] = a7; o[8 * 9216] = a8;
        }
    }
    transpose_range(p, lds, 0, 2 * LF_TILES, bid, G);
    transpose_range(p, lds, 8 * LF_TILES, p->ntiles_total, bid, G);
    const size_t gtid = (size_t)bid * 512 + tid, gsz = (size_t)G * 512;
    {
        bf16_t* dst = (bf16_t*)(ws + OFF_WFING);
        for (size_t e = gtid; e < (size_t)2 * 1024 * 1024 / 4; e += gsz) {
            const size_t e4 = e * 4; const int i = (int)(e4 >> 20), k = (int)((e4 >> 10) & 1023), col = (int)(e4 & 1023), g = col >> 8, c = col & 255;
            const f32x4 v = *(const f32x4*)(p->f_w_in + e4);
            u32x2 o; o.x = cvt_pk_bf16(v[0], v[1]); o.y = cvt_pk_bf16(v[2], v[3]);
            *(u32x2*)(dst + (((size_t)(i * 4 + g) * 1024 + k) << 8) + c) = o;
        }
    }
    {
        bf16_t* cst = (bf16_t*)(ws + OFF_CST);
        for (size_t e = gtid; e < (size_t)512 * 256; e += gsz) { const int r = (int)(e >> 8), c = (int)(e & 255), s = r >> 8, m = r & 255;
            const float rev = (float)((m * c) & 255) * (1.f / 256.f);
            cst[e] = f2bf(s ? __builtin_amdgcn_sinf(rev) : __builtin_amdgcn_cosf(rev)); }
        bf16_t* twl = (bf16_t*)(ws + OFF_TWLAT);
        for (size_t e = gtid; e < (size_t)2048 * 4096; e += gsz) { const int kf = (int)(e >> 12), cc = (int)(e & 4095), s = cc >> 11, l = cc & 2047;
            const float rev = (float)((kf * l) & 2047) * (1.f / 2048.f);
            twl[e] = f2bf(s ? -__builtin_amdgcn_sinf(rev) : __builtin_amdgcn_cosf(rev)); }
        bf16_t* twc = (bf16_t*)(ws + OFF_TWCTX);
        for (size_t e = gtid; e < (size_t)256 * 512; e += gsz) { const int kf = (int)(e >> 9), cc = (int)(e & 511), s = cc >> 8, l = cc & 255;
            const float rev = (float)((kf * l) & 255) * (1.f / 256.f);
            twc[e] = f2bf(s ? -__builtin_amdgcn_sinf(rev) : __builtin_amdgcn_cosf(rev)); }
    }
}
__device__ __forceinline__ void phase_p1_mods(KP p) {
    const size_t gtid = (size_t)blockIdx.x * 512 + ltid(), gsz = (size_t)gridDim.x * 512;
    const float* modp = (const float*)(p->ws + OFF_SCR + SCR_MODP);
    float* mods = (float*)(p->ws + OFF_MODS);
    for (size_t e = gtid; e < (size_t)4 * 9 * 9216; e += gsz) {
        const int l = (int)(e / (9 * 9216)), n = (int)(e % 9216);
        float a = p->b_ada[l * 9216 + n];
#pragma unroll
        for (int kc = 0; kc < 8; ++kc) a += modp[(size_t)kc * 4 * 9 * 9216 + e];
        mods[e] = a;
    }
}
__device__ __forceinline__ f32x4 bf4_to_f32(u32x2 u) { f32x4 r; r[0] = __uint_as_float(u.x << 16); r[1] = __uint_as_float(u.x & 0xffff0000u); r[2] = __uint_as_float(u.y << 16); r[3] = __uint_as_float(u.y & 0xffff0000u); return r; }
template <bool DO_LN>
__device__ __forceinline__ void phase_ln(KP p, const float* g_, const float* b_, const float* gate, const float* shift, const float* scale, bool write_h) {
    constexpr int NR = 2;
    const int lane = ltid() & 63, wave = ltid() >> 6;
    const bf16_t* BR = (const bf16_t*)(p->ws + OFF_SCR + SCR_Z1);
    bf16_t* H = (bf16_t*)(p->ws + OFF_HMOD); _Float16* YB = (_Float16*)(p->ws + OFF_Z);
    const int stride = gridDim.x * 8;
    for (int row0 = blockIdx.x * 8 + wave; row0 < T; row0 += NR * stride) {
        f32x4 v[NR][4];
#pragma unroll
        for (int r = 0; r < NR; ++r) { const int row = row0 + r * stride;
            if (row < T) {
                if (DO_LN) {
                    const float* gp = gate + (size_t)modrow_of(row) * 9216;
#pragma unroll
                    for (int j = 0; j < 4; ++j) { const size_t o = (size_t)row * D + 4 * lane + 256 * j;
                        const f32x4 y = __builtin_convertvector(*(const f16x4_t*)(YB + o), f32x4);
                        const f32x4 b0 = bf4_to_f32(*(const u32x2*)(BR + o)), b1 = bf4_to_f32(*(const u32x2*)(BR + (size_t)T * D + o));
                        v[r][j] = y * ALPHA + *(const f32x4*)(gp + 4 * lane + 256 * j) * (b0 + b1); }
                } else { const float* src = row < TC ? p->x_prompt + (size_t)row * D : p->x_sample + (size_t)(row - TC) * D;
#pragma unroll
                    for (int j = 0; j < 4; ++j) v[r][j] = *(const f32x4*)(src + 4 * lane + 256 * j); }
            } else {
#pragma unroll
                for (int j = 0; j < 4; ++j) v[r][j] = (f32x4){0.f, 0.f, 0.f, 0.f};
            } }
#pragma unroll
        for (int r = 0; r < NR; ++r) { const int row = row0 + r * stride;
            if (row >= T) break;
            if (DO_LN) {
                float s = 0.f;
#pragma unroll
                for (int j = 0; j < 4; ++j) s += (v[r][j][0] + v[r][j][1]) + (v[r][j][2] + v[r][j][3]);
                const float mean = wave_sum(s) * (1.f / D);
                float s2 = 0.f;
#pragma unroll
                for (int j = 0; j < 4; ++j) { v[r][j] = v[r][j] - mean; s2 += (v[r][j][0] * v[r][j][0] + v[r][j][1] * v[r][j][1]) + (v[r][j][2] * v[r][j][2] + v[r][j][3] * v[r][j][3]); }
                const float rstd = __builtin_amdgcn_rsqf(wave_sum(s2) * (1.f / D) + 1e-5f);
#pragma unroll
                for (int j = 0; j < 4; ++j) { const f32x4 gg = *(const f32x4*)(g_ + 4 * lane + 256 * j), bb = *(const f32x4*)(b_ + 4 * lane + 256 * j); v[r][j] = v[r][j] * rstd * gg + bb; }
            }
            if (write_h) {
#pragma unroll
                for (int j = 0; j < 4; ++j) *(f16x4_t*)(YB + (size_t)row * D + 4 * lane + 256 * j) = __builtin_convertvector(v[r][j], f16x4_t);
            } else {
                float* y = p->out + (size_t)row * D;
#pragma unroll
                for (int j = 0; j < 4; ++j) *(f32x4*)(y + 4 * lane + 256 * j) = v[r][j];
            }
            if (write_h) {
                const int mr = modrow_of(row);
#pragma unroll
                for (int j = 0; j < 4; ++j) { const f32x4 sh = *(const f32x4*)(shift + (size_t)mr * 9216 + 4 * lane + 256 * j), sc = *(const f32x4*)(scale + (size_t)mr * 9216 + 4 * lane + 256 * j);
                    const f32x4 h = v[r][j] * (sc + 1.f) + sh;
                    u32x2 o; o.x = cvt_pk_bf16(h[0], h[1]); o.y = cvt_pk_bf16(h[2], h[3]);
                    *(u32x2*)(H + (size_t)row * D + 4 * lane + 256 * j) = o; }
            }
        }
    }
}

__device__ __forceinline__ void phase_postproj(KP p, int i) {
    const int lane = ltid() & 63, wave = ltid() >> 6;
    unsigned char* scr = p->ws + OFF_SCR;
    const bf16_t* proj = (const bf16_t*)(scr + SCR_PROJ);
    bf16_t* QA = (bf16_t*)(scr + SCR_QA); bf16_t* KA = (bf16_t*)(scr + SCR_KA); bf16_t* VAT = (bf16_t*)(scr + SCR_VAT);
    bf16_t* CQN = (bf16_t*)(scr + SCR_CQN); bf16_t* CKVN = (bf16_t*)(scr + SCR_CKVN); bf16_t* KPE = (bf16_t*)(scr + SCR_KPE);
    for (int kr = blockIdx.x * 8 + wave; kr < KR; kr += gridDim.x * 8) {
        int t, l = 0; bool ctx;
        if (kr < TC) { t = kr; ctx = true; l = kr & 255; }
        else {
            const int b = (kr - TC) / 2304, j = (kr - TC) % 2304;
            if (j < 256) {
                const size_t cr = (size_t)((b * 2 + i) * 256 + j);
                const float* ck = p->cache_a_k + cr * 128; const float* cv = p->cache_a_v + cr * 128;
                KA[(size_t)kr * 128 + lane] = f2bf(ck[lane]); KA[(size_t)kr * 128 + 64 + lane] = f2bf(ck[64 + lane]);
                VAT[(size_t)lane * KR + kr] = f2bf(cv[lane]); VAT[(size_t)(64 + lane) * KR + kr] = f2bf(cv[64 + lane]);
                const f32x4 cc = *(const f32x4*)(p->cache_b_ckv + cr * 256 + 4 * lane);
                u32x2 o; o.x = cvt_pk_bf16(cc[0], cc[1]); o.y = cvt_pk_bf16(cc[2], cc[3]);
                *(u32x2*)(CKVN + (size_t)kr * 256 + 4 * lane) = o;
                if (lane < 32) KPE[(size_t)kr * 32 + lane] = f2bf(p->cache_b_kpe[cr * 32 + lane]);
                continue;
            }
            l = j - 256; t = TC + b * 2048 + l; ctx = false;
        }
        const bf16_t* srcb = proj + (size_t)t * 1536;
#define PJ(i_) __uint_as_float(((unsigned)srcb[(i_)]) << 16)
        const float prow = (float)(l >> 6), pcol = (float)(l & 63);
#pragma unroll
        for (int q = 0; q < 4; ++q) { const int pidx = lane + 64 * q, head = pidx >> 5, pp = pidx & 31, d1 = pp < 16 ? pp : pp + 16, d2 = d1 + 16;
            float x1 = PJ(head * 64 + d1), x2 = PJ(head * 64 + d2);
            if (!ctx) { const float rev = (pp < 16 ? prow : pcol) * (__builtin_amdgcn_exp2f(-(float)(pp & 15) * (LOG2_10000 / 16.f)) * INV2PI);
                const float cs = __builtin_amdgcn_cosf(rev), sn = __builtin_amdgcn_sinf(rev);
                const float o1 = x1 * cs - x2 * sn, o2 = x2 * cs + x1 * sn; x1 = o1; x2 = o2; }
            QA[(size_t)t * 512 + head * 64 + d1] = f2bf(x1 * QA_SCALE); QA[(size_t)t * 512 + head * 64 + d2] = f2bf(x2 * QA_SCALE); }
        { const int head = lane >> 5, pp = lane & 31, d1 = pp < 16 ? pp : pp + 16, d2 = d1 + 16;
            float x1 = PJ(512 + head * 64 + d1), x2 = PJ(512 + head * 64 + d2);
            if (ctx) { float* o = p->out + O_AK + ((size_t)(((kr >> 8) * 2 + i) * 256 + l)) * 128 + head * 64; o[d1] = x1; o[d2] = x2; }
            else { const float rev = (pp < 16 ? prow : pcol) * (__builtin_amdgcn_exp2f(-(float)(pp & 15) * (LOG2_10000 / 16.f)) * INV2PI);
                const float cs = __builtin_amdgcn_cosf(rev), sn = __builtin_amdgcn_sinf(rev);
                const float o1 = x1 * cs - x2 * sn, o2 = x2 * cs + x1 * sn; x1 = o1; x2 = o2; }
            KA[(size_t)kr * 128 + head * 64 + d1] = f2bf(x1); KA[(size_t)kr * 128 + head * 64 + d2] = f2bf(x2); }
        { const float v0 = PJ(640 + lane), v1 = PJ(704 + lane);
            VAT[(size_t)lane * KR + kr] = f2bf(v0); VAT[(size_t)(64 + lane) * KR + kr] = f2bf(v1);
            if (ctx) { float* o = p->out + O_AV + ((size_t)(((kr >> 8) * 2 + i) * 256 + l)) * 128; o[lane] = v0; o[64 + lane] = v1; } }
        { float x[6]; float ss = 0.f;
#pragma unroll
            for (int q = 0; q < 6; ++q) { x[q] = PJ(768 + lane + 64 * q); ss += x[q] * x[q]; }
            const float r = __builtin_amdgcn_rsqf(wave_sum(ss) * (1.f / 384.f) + 1e-6f);
#pragma unroll
            for (int q = 0; q < 6; ++q) CQN[(size_t)t * 384 + lane + 64 * q] = f2bf(x[q] * r * p->b_g_cq[i * 384 + lane + 64 * q]); }
        { const f32x4 x = bf4_to_f32(*(const u32x2*)(srcb + 1152 + 4 * lane));
            const float ss = (x[0] * x[0] + x[1] * x[1]) + (x[2] * x[2] + x[3] * x[3]);
            const float r = __builtin_amdgcn_rsqf(wave_sum(ss) * (1.f / 256.f) + 1e-6f);
            const f32x4 g = *(const f32x4*)(p->b_g_ckv + i * 256 + 4 * lane);
            const f32x4 y = x * r * g;
            u32x2 o; o.x = cvt_pk_bf16(y[0], y[1]); o.y = cvt_pk_bf16(y[2], y[3]);
            *(u32x2*)(CKVN + (size_t)kr * 256 + 4 * lane) = o;
            if (ctx) *(f32x4*)(p->out + O_CKV + ((size_t)(((kr >> 8) * 2 + i) * 256 + l)) * 256 + 4 * lane) = y; }
        if (lane < 16) { const int d1 = lane < 8 ? lane : lane + 8, d2 = d1 + 8;
            float x1 = PJ(1408 + d1), x2 = PJ(1408 + d2);
            if (ctx) { float* o = p->out + O_KPE + ((size_t)(((kr >> 8) * 2 + i) * 256 + l)) * 32; o[d1] = x1; o[d2] = x2; }
            else { const float rev = (lane < 8 ? prow : pcol) * (__builtin_amdgcn_exp2f(-(float)(lane & 7) * (LOG2_10000 / 8.f)) * INV2PI);
                const float cs = __builtin_amdgcn_cosf(rev), sn = __builtin_amdgcn_sinf(rev);
                const float o1 = x1 * cs - x2 * sn, o2 = x2 * cs + x1 * sn; x1 = o1; x2 = o2; }
            KPE[(size_t)kr * 32 + d1] = f2bf(x1); KPE[(size_t)kr * 32 + d2] = f2bf(x2); }
    }
}

#undef PJ
template <bool IS_B>
__device__ __forceinline__ void attn_item(LAS unsigned char* lds, KP p, bool lat, int b, int h, int qblk, int li) {
    constexpr int DQK = IS_B ? 96 : 64, KSTR = DQK + 8, VSTR = 72;
    unsigned char* scr = p->ws + OFF_SCR;
    const int tid = ltid(), wave = tid >> 6, lane = tid & 63, qi = lane & 15, quad = lane >> 4;
    int q_tok0, kbase, ntiles, lo = 0;
    if (lat) { q_tok0 = TC + b * 2048 + qblk * 256; kbase = TC + b * 2304;
        if (IS_B) ntiles = 36; else { lo = qblk * 256 - 128; if (lo < 0) lo = 0; int hi = qblk * 256 + 384; if (hi > 2048) hi = 2048; ntiles = 4 + ((hi - lo) >> 6); } }
    else { q_tok0 = b * 256; kbase = b * 256; ntiles = 4; }
    const bf16_t* Q = (const bf16_t*)(scr + (IS_B ? SCR_QB : SCR_QA)); constexpr int ldq = IS_B ? 768 : 512;
    bf16x8 qf[2][DQK / 32];
#pragma unroll
    for (int qt = 0; qt < 2; ++qt) { const bf16_t* qp = Q + (size_t)(q_tok0 + wave * 32 + qt * 16 + qi) * ldq + h * DQK + quad * 8;
#pragma unroll
        for (int kk = 0; kk < DQK / 32; ++kk) qf[qt][kk] = *(const bf16x8*)(qp + 32 * kk); }
    float m_run[2], l_run[2];
#pragma unroll
    for (int qt = 0; qt < 2; ++qt) { if (IS_B) { m_run[qt] = -1e30f; l_run[qt] = 0.f; } else { m_run[qt] = p->a_sink[li * 8 + h] * LOG2E; l_run[qt] = (quad == 0) ? 1.f : 0.f; } }
    f32x4 o[2][4];
#pragma unroll
    for (int qt = 0; qt < 2; ++qt)
#pragma unroll
        for (int d = 0; d < 4; ++d) o[qt][d] = (f32x4){0.f, 0.f, 0.f, 0.f};
    const int kvh = h >> 2;
    const bf16_t* KN = (const bf16_t*)(scr + SCR_KN); const bf16_t* KPE = (const bf16_t*)(scr + SCR_KPE); const bf16_t* KA = (const bf16_t*)(scr + SCR_KA);
    const bf16_t* VT = (const bf16_t*)(scr + (IS_B ? SCR_VT : SCR_VAT));
    constexpr int BUF = 64 * KSTR + 64 * VSTR;
    const int r0 = IS_B ? tid / 12 : tid >> 3, c0 = IS_B ? tid % 12 : tid & 7;
    const int r1 = (tid + 512) / 12, c1 = (tid + 512) % 12;
    const int vd = tid >> 3, vc = tid & 7;
    const bf16_t* vrow = VT + (size_t)((IS_B ? h : kvh) * 64 + vd) * KR + vc * 8;
    u32x4 kreg0, kreg1 = (u32x4){0u, 0u, 0u, 0u}, vreg;
#define ATT_KR0(it_) ((!IS_B && lat && (it_) >= 4) ? kbase + 256 + lo + 64 * ((it_) - 4) : kbase + 64 * (it_))
#define ATT_LOAD(it_) do { const int kr_ = ATT_KR0(it_); \
        if (IS_B) { kreg0 = c0 < 8 ? *(const u32x4*)(KN + (size_t)(kr_ + r0) * 512 + h * 64 + c0 * 8) : *(const u32x4*)(KPE + (size_t)(kr_ + r0) * 32 + (c0 - 8) * 8); \
            if (tid < 256) kreg1 = c1 < 8 ? *(const u32x4*)(KN + (size_t)(kr_ + r1) * 512 + h * 64 + c1 * 8) : *(const u32x4*)(KPE + (size_t)(kr_ + r1) * 32 + (c1 - 8) * 8); } \
        else kreg0 = *(const u32x4*)(KA + (size_t)(kr_ + r0) * 128 + kvh * 64 + c0 * 8); \
        vreg = *(const u32x4*)(vrow + kr_); } while (0)
#define ATT_STORE(buf_) do { LAS bf16_t* kb_ = (LAS bf16_t*)lds + (buf_) * BUF; \
        *(LAS u32x4*)(kb_ + r0 * KSTR + c0 * 8) = kreg0; \
        if (IS_B && tid < 256) *(LAS u32x4*)(kb_ + r1 * KSTR + c1 * 8) = kreg1; \
        *(LAS u32x4*)(kb_ + 64 * KSTR + vd * VSTR + vc * 8) = vreg; } while (0)
    __syncthreads();
    ATT_LOAD(0); ATT_STORE(0);
    if (ntiles > 1) ATT_LOAD(1);
    __syncthreads();
    const int qa = qblk * 256 + wave * 32;
    for (int it = 0; it < ntiles; ++it) {
        int kpos0 = 0; bool masked = false;
        if (!IS_B && lat && it >= 4) { kpos0 = lo + 64 * (it - 4); masked = true; }
        if (it + 1 < ntiles) ATT_STORE((it + 1) & 1);
        if (it + 2 < ntiles) ATT_LOAD(it + 2);
        const bool need = !masked || (kpos0 <= qa + 31 + 128 && kpos0 + 63 >= qa - 128);
        if (need) {
            LAS bf16_t* Ks = (LAS bf16_t*)lds + (it & 1) * BUF; LAS bf16_t* Vs = Ks + 64 * KSTR;
            f32x4 s[2][4];
#pragma unroll
            for (int kt = 0; kt < 4; ++kt) {
#pragma unroll
                for (int qt = 0; qt < 2; ++qt) s[qt][kt] = (f32x4){0.f, 0.f, 0.f, 0.f};
#pragma unroll
                for (int kk = 0; kk < DQK / 32; ++kk) { const bf16x8 a = *(const LAS bf16x8*)(Ks + (kt * 16 + qi) * KSTR + quad * 8 + 32 * kk);
#pragma unroll
                    for (int qt = 0; qt < 2; ++qt) s[qt][kt] = __builtin_amdgcn_mfma_f32_16x16x32_bf16(a, qf[qt][kk], s[qt][kt], 0, 0, 0); } }
            u32x4 pbu[2][2];
#pragma unroll
            for (int qt = 0; qt < 2; ++qt) {
                if (masked) { const int qpos = qa + qt * 16 + qi;
#pragma unroll
                    for (int kt = 0; kt < 4; ++kt)
#pragma unroll
                        for (int j = 0; j < 4; ++j) { const int dd = qpos - (kpos0 + kt * 16 + quad * 4 + j); if (dd > 128 || dd < -128) s[qt][kt][j] = -1e30f; } }
                float tmax = s[qt][0][0];
#pragma unroll
                for (int kt = 0; kt < 4; ++kt)
#pragma unroll
                    for (int j = 0; j < 4; ++j) tmax = fmaxf(tmax, s[qt][kt][j]);
                tmax = xor16_max(tmax); tmax = xor32_max(tmax);
                const float m_new = fmaxf(m_run[qt], tmax), alpha = __builtin_amdgcn_exp2f(m_run[qt] - m_new); m_run[qt] = m_new;
                float psum = 0.f;
#pragma unroll
                for (int kt = 0; kt < 4; ++kt)
#pragma unroll
                    for (int j = 0; j < 4; ++j) { const float e = __builtin_amdgcn_exp2f(s[qt][kt][j] - m_new); s[qt][kt][j] = e; psum += e; }
                l_run[qt] = l_run[qt] * alpha + psum;
#pragma unroll
                for (int d = 0; d < 4; ++d) o[qt][d] = o[qt][d] * alpha;
#pragma unroll
                for (int ks = 0; ks < 2; ++ks) { pbu[qt][ks].x = cvt_pk_bf16(s[qt][2 * ks][0], s[qt][2 * ks][1]); pbu[qt][ks].y = cvt_pk_bf16(s[qt][2 * ks][2], s[qt][2 * ks][3]);
                    pbu[qt][ks].z = cvt_pk_bf16(s[qt][2 * ks + 1][0], s[qt][2 * ks + 1][1]); pbu[qt][ks].w = cvt_pk_bf16(s[qt][2 * ks + 1][2], s[qt][2 * ks + 1][3]); }
            }
#pragma unroll
            for (int ks = 0; ks < 2; ++ks)
#pragma unroll
                for (int d = 0; d < 4; ++d) {
                    const u32x2 vlo = *(const LAS u32x2*)(Vs + (d * 16 + qi) * VSTR + (2 * ks) * 16 + quad * 4);
                    const u32x2 vhi = *(const LAS u32x2*)(Vs + (d * 16 + qi) * VSTR + (2 * ks + 1) * 16 + quad * 4);
                    u32x4 au; au.x = vlo.x; au.y = vlo.y; au.z = vhi.x; au.w = vhi.y;
                    const bf16x8 av = __builtin_bit_cast(bf16x8, au);
#pragma unroll
                    for (int qt = 0; qt < 2; ++qt) o[qt][d] = __builtin_amdgcn_mfma_f32_16x16x32_bf16(av, __builtin_bit_cast(bf16x8, pbu[qt][ks]), o[qt][d], 0, 0, 0);
                }
        }
        __syncthreads();
    }
#undef ATT_KR0
#undef ATT_LOAD
#undef ATT_STORE
#pragma unroll
    for (int qt = 0; qt < 2; ++qt) {
        const float lt = xor32_sum(xor16_sum(l_run[qt]));
        const float inv = 1.f / lt;
        bf16_t* op = (bf16_t*)(scr + SCR_AO) + (size_t)(q_tok0 + wave * 32 + qt * 16 + qi) * 1024 + (IS_B ? 512 : 0) + h * 64 + quad * 4;
#pragma unroll
        for (int d = 0; d < 4; ++d) { u32x2 ov; ov.x = cvt_pk_bf16(o[qt][d][0] * inv, o[qt][d][1] * inv); ov.y = cvt_pk_bf16(o[qt][d][2] * inv, o[qt][d][3] * inv); *(u32x2*)(op + d * 16) = ov; }
    }
}
__device__ __forceinline__ void phase_attn(KP p, LAS unsigned char* lds, int li) {
    for (int it = blockIdx.x; it < 1280; it += gridDim.x) {
        bool isB, lat; int b, h, qb;
        if (it < 1024) { lat = true; isB = it < 512; const int x = it & 511; b = x >> 6; h = (x >> 3) & 7; qb = x & 7; }
        else { lat = false; const int x = (it - 1024) & 127; isB = it < 1152; b = x >> 3; h = x & 7; qb = 0; }
        if (isB) attn_item<true>(lds, p, lat, b, h, qb, li); else attn_item<false>(lds, p, lat, b, h, qb, li);
    }
}

enum { E_F32 = 0, E_BF16 = 1, E_SWIGLU = 2, E_RESID = 3, E_QB = 4, E_PT = 5 };
struct GCall { int type; pg8::Gemm g; void* o; int ldc; float scale; size_t zoff; int pm_stride; const float* gate; float gs; int rot; int xlf; };

__device__ __forceinline__ void run_gemm(LAS unsigned char* lds, KP p, const GCall& c) {
    pg8::Order S; S.init(c.g.M, c.g.N, c.g.nz, gridDim.x, (int)((blockIdx.x + c.rot) % gridDim.x));
#ifndef TMASK
#define TMASK 62
#endif
    switch (c.type) {
    case E_F32: if (TMASK & 1) { pg8::EpiStoreF32 e{(float*)c.o, c.ldc}; pg8::gemm_phase(lds, c.g, S, e); break; }
    case E_BF16: if (TMASK & 2) { pg8::EpiStoreBf16 e{(bf16_t*)c.o, c.ldc, c.scale, c.zoff, c.pm_stride}; pg8::gemm_phase(lds, c.g, S, e);
        if (c.xlf >= 0) {
            if (gridDim.x == 256) { if (blockIdx.x >= 128) transpose_range(p, lds, c.xlf * LF_TILES, (c.xlf + 1) * LF_TILES, (int)blockIdx.x - 128, 128); }
            else transpose_range(p, lds, c.xlf * LF_TILES, (c.xlf + 1) * LF_TILES, (int)blockIdx.x, (int)gridDim.x);
        }
        break; }
    case E_SWIGLU: if (TMASK & 4) { pg8::EpiSwiGLU e{(bf16_t*)c.o}; pg8::gemm_phase(lds, c.g, S, e); break; }
    case E_QB: if (TMASK & 16) { pg8::EpiQb e{(bf16_t*)c.o}; pg8::gemm_phase(lds, c.g, S, e); break; }
    default: if (TMASK & 32) { pg8::EpiPt e{(bf16_t*)(p->ws + OFF_SCR + SCR_PTL), (bf16_t*)(p->ws + OFF_SCR + SCR_PTC)}; pg8::gemm_phase(lds, c.g, S, e); break; }
    }
}

__device__ __forceinline__ pg8::Gemm mk_gemm(const void* A, const void* Bt, int M, int N, int K, int nz = 1, size_t zA = 0, size_t zB = 0) {
    pg8::Gemm g; g.A = (const bf16_t*)A; g.Bt = (const bf16_t*)Bt; g.M = M; g.N = N; g.K = K; g.ld = K; g.nz = nz; g.zA = zA; g.zB = zB; return g;
}

__device__ __forceinline__ bool build_call(KP p, int ph, int k, GCall& c) {
    unsigned char* ws = p->ws; unsigned char* scr = ws + OFF_SCR;
    const float* mods = (const float*)(ws + OFF_MODS);
#define MODP(l, idx) (mods + (size_t)(l) * 9 * 9216 + (idx) * 1024)
    c.type = E_BF16; c.o = nullptr; c.ldc = 0; c.scale = 1.f; c.zoff = 0; c.pm_stride = 256; c.gate = nullptr; c.gs = 0.f; c.rot = 0; c.xlf = -1;
    c.g = mk_gemm(nullptr, nullptr, 0, 0, 256);
    if (ph == 0 || ph == 2) return false;
    if (ph == 1) {
        if (k >= 2) return false;
        const int i = k;
        c.g = mk_gemm(ws + OFF_CST, ws + OFF_WFING + (size_t)i * 4 * 1024 * 256 * 2, 512, 1024, 256, 4, 0, (size_t)1024 * 256 * 2);
        c.o = ws + OFF_WFOLD + (size_t)i * 2048 * 1024 * 2; c.ldc = 1024; c.zoff = (size_t)256 * 1024; c.pm_stride = 1024; c.rot = i * 32; return true;
    }
    int q = ph - 3, l;
    if (q < 12) l = 0; else if (q < 22) { l = 1; q -= 12; } else if (q < 34) { l = 2; q -= 22; } else { l = 3; q -= 34; }
    const int i = l >> 1; const bool even = (l & 1) == 0;
    int code;
    if (q < 3) code = q; else { const int nm = even ? 5 : 3; code = (q < 3 + nm) ? 10 + (q - 3) : 100 + (q - 3 - nm); }
    if (code == 0 || code == 101) { if (k) return false; const int f = code == 0 ? 0 : 1; c.type = E_SWIGLU;
        c.g = mk_gemm(ws + OFF_HMOD, ws + OFF_W1T + (size_t)(l * 2 + f) * 5632 * 1024 * 2, T, 5632, 1024); c.o = scr + SCR_HFF; return true; }
    if (code == 1 || code == 102) { if (k) return false; const int f = code == 1 ? 0 : 1; c.type = E_BF16; c.o = scr + SCR_Z1; c.ldc = 1024; c.zoff = (size_t)T * 1024; c.scale = 0.5f;
        c.g = mk_gemm(scr + SCR_HFF, ws + OFF_W2T + (size_t)(l * 2 + f) * 1024 * 2816 * 2, T, 1024, 1408, 2, 1408 * 2, 1408 * 2); c.g.ld = 2816; c.xlf = l < 3 ? 2 * (l + 1) + f : -1; return true; }
    if (code == 2 || code >= 100) return false;
    if (even) {
        if (code == 10) { if (k) return false;
            c.g = mk_gemm(ws + OFF_HMOD, ws + OFF_WINT + (size_t)i * 1536 * 1024 * 2, T, 1536, 1024); c.o = scr + SCR_PROJ; c.ldc = 1536; return true; }
        if (code == 12) {
            if (k == 0) { c.type = E_QB; c.g = mk_gemm(scr + SCR_CQN, ws + OFF_WUQT + (size_t)i * 768 * 384 * 2, T, 768, 384); c.o = scr + SCR_QB; return true; }
            if (k == 1) { c.g = mk_gemm(scr + SCR_CKVN, ws + OFF_WUKT + (size_t)i * 512 * 256 * 2, KR, 512, 256); c.o = scr + SCR_KN; c.ldc = 512; c.rot = 240; return true; }
            if (k == 2) { c.g = mk_gemm(ws + OFF_WUVT + (size_t)i * 512 * 256 * 2, scr + SCR_CKVN, 512, KR, 256); c.o = scr + SCR_VT; c.ldc = KR; c.rot = 160; return true; }
            return false;
        }
        if (code == 14) { if (k) return false; c.type = E_BF16; c.o = scr + SCR_Z1; c.ldc = 1024; c.zoff = (size_t)T * 1024;
            c.g = mk_gemm(scr + SCR_AO, ws + OFF_WOUTT + (size_t)i * 1024 * 1024 * 2, T, 1024, 512, 2, 512 * 2, 512 * 2); c.g.ld = 1024; return true; }
        return false;
    }
    if (code == 10) { if (k) return false; c.type = E_PT; c.g = mk_gemm(ws + OFF_WFOLD + (size_t)i * 2048 * 1024 * 2, ws + OFF_HMOD, 2048, T, 1024); return true; }
    if (code == 11) {
        if (k == 0) { c.g = mk_gemm(ws + OFF_TWLAT, scr + SCR_PTL, 2048, 1024, 4096, 8, 0, (size_t)1024 * 4096 * 2);
            c.o = scr + SCR_FM + (size_t)TC * 1024 * 2; c.ldc = 1024; c.scale = 0.001381067932004975f; c.zoff = (size_t)2048 * 1024; return true; }
        if (k == 1) { c.g = mk_gemm(ws + OFF_TWCTX, scr + SCR_PTC, 256, 1024, 512, 16, 0, (size_t)1024 * 512 * 2);
            c.o = scr + SCR_FM; c.ldc = 1024; c.scale = 0.00390625f; c.zoff = (size_t)256 * 1024; return true; }
        return false;
    }
    if (code == 12) { if (k) return false; c.type = E_BF16; c.o = scr + SCR_Z1; c.ldc = 1024; c.zoff = (size_t)T * 1024;
        c.g = mk_gemm(scr + SCR_FM, ws + OFF_WFOUTT + (size_t)i * 1024 * 1024 * 2, T, 1024, 512, 2, 512 * 2, 512 * 2); c.g.ld = 1024; return true; }
    return false;
}
__device__ __forceinline__ void run_simple(KP p, LAS unsigned char* lds, int ph) {
    const float* mods = (const float*)(p->ws + OFF_MODS);
#ifndef SMASK
#define SMASK 31
#endif
    if (ph == 0) { if (SMASK & 1) phase_p0(p, lds); return; }
    if (ph == 1) { if (SMASK & 2) phase_p1_mods(p); return; }
    int q = ph - 3, l = 0; bool first = ph == 2;
    if (!first) { if (q < 12) l = 0; else if (q < 22) { l = 1; q -= 12; } else if (q < 34) { l = 2; q -= 22; } else { l = 3; q -= 34; } }
    const int i = l >> 1; const bool even = (l & 1) == 0;
    int code = 0;
    if (!first) { if (q < 3) code = q; else { const int nm = even ? 5 : 3; code = (q < 3 + nm) ? 10 + (q - 3) : 100 + (q - 3 - nm); } }
    int lnk = -1, ml = l, ms = 0; bool wh = true;
    if (first) { lnk = 0; ml = 0; ms = 0; }
    else if (code == 2) { lnk = 0; ms = 3; }
    else if (code == 100) { lnk = 1; ms = 6; }
    else if (code == 103) { lnk = 2; ml = l < 3 ? l + 1 : 3; ms = 0; wh = l < 3; }
    if (lnk >= 0) {
        const float* g_ = p->ln_g + (l * 3 + lnk) * 1024; const float* b_ = p->ln_b + (l * 3 + lnk) * 1024;
        const float* sh = MODP(ml, ms); const float* sc = MODP(ml, ms + 1); const float* gt = MODP(l, 2 + 3 * lnk);
        if (SMASK & 4) { if (first) phase_ln<false>(p, g_, b_, gt, sh, sc, true); else phase_ln<true>(p, g_, b_, gt, sh, sc, wh); }
        return;
    }
    if (even && code == 11) { if (SMASK & 8) phase_postproj(p, i); return; }
    if (even && code == 13) { if (SMASK & 16) phase_attn(p, lds, i); return; }
#undef MODP
}
__device__ __forceinline__ void run_phase(KP p, LAS unsigned char* lds, int ph) {
    run_simple(p, lds, ph);
    for (int k = 0; k < 3; ++k) { GCall c; if (!build_call(p, ph, k, c)) break; run_gemm(lds, p, c); }
}

#ifndef REPEAT_MASK
#define REPEAT_MASK 0
#endif
#define XB_TMO      128
#define XB_XCNT(j)  (256  + 64 * (j))
#define XB_XSUB(j)  (1280 + 64 * (j))
#define XB_XGEN(j)  (2304 + 64 * (j))
#define XB_TOP      3328
#define XB_TOPGEN   3392
#define XCD_BAR_WORDS 3456
#define XB_SPIN_CAP (1u << 18)

__device__ __forceinline__ unsigned xb_ld(unsigned* p)              { return __hip_atomic_load(p, __ATOMIC_RELAXED, __HIP_MEMORY_SCOPE_AGENT); }
__device__ __forceinline__ unsigned xb_add(unsigned* p, unsigned v) { return __hip_atomic_fetch_add(p, v, __ATOMIC_RELAXED, __HIP_MEMORY_SCOPE_AGENT); }
__device__ __forceinline__ unsigned xb_xcc_id() { return (unsigned)__builtin_amdgcn_s_getreg((3 << 11) | 20) & 0xFu; }
#define XB_SPIN(cond, bar) do { unsigned _sp = 0; while (cond) { __builtin_amdgcn_s_sleep(1); \
    if ((++_sp & 255u) == 0u) { if (xb_ld(&(bar)[XB_TMO])) break; if (_sp > XB_SPIN_CAP) { atomicAdd(&(bar)[XB_TMO], 1u); break; } } } } while (0)

struct XcdBarrier {
    unsigned* bar; unsigned x;
    volatile LAS unsigned* st;
};

__device__ __forceinline__ XcdBarrier xcd_barrier_post(unsigned* bar, volatile LAS unsigned* st) {
    XcdBarrier b; b.bar = bar; b.x = xb_xcc_id(); b.st = st;
    if (threadIdx.x == 0) (void)xb_add(&bar[XB_XCNT(b.x)], 1u);
    return b;
}
__device__ __forceinline__ void xcd_barrier_complete(unsigned* bar, unsigned x, unsigned& nloc, unsigned& nx) {
    const unsigned G = gridDim.x * gridDim.y * gridDim.z;
    unsigned sum, cnt, mine, sp = 0u;
    for (;;) {
        sum = 0u; cnt = 0u; mine = 0u;
#pragma unroll
        for (unsigned j = 0; j < 16; ++j) { const unsigned c = xb_ld(&bar[XB_XCNT(j)]); sum += c; cnt += (c > 0u) ? 1u : 0u; mine = (j == x) ? c : mine; }
        if (sum == G) break;
        __builtin_amdgcn_s_sleep(1);
        if ((++sp & 255u) == 0u) { if (xb_ld(&bar[XB_TMO])) break; if (sp > XB_SPIN_CAP) { atomicAdd(&bar[XB_TMO], 1u); break; } }
    }
    nloc = mine > 0u ? mine : 1u; nx = cnt > 0u ? cnt : 1u;
}

__device__ __forceinline__ void xcd_barrier(const XcdBarrier& b) {
    asm volatile("s_waitcnt vmcnt(0)" ::: "memory");
    __syncthreads();
    if (threadIdx.x == 0) {
        unsigned* bar = b.bar;
        __builtin_amdgcn_s_waitcnt(0);
        unsigned nloc = b.st[0], nx = b.st[1];
        if (nloc == 0u) { xcd_barrier_complete(bar, b.x, nloc, nx); b.st[0] = nloc; b.st[1] = nx; }
        const unsigned old = xb_add(&bar[XB_XSUB(b.x)], 1u);
        const unsigned gen = old / nloc;
        if (old + 1u == (gen + 1u) * nloc) {
            __builtin_amdgcn_fence(__ATOMIC_RELEASE, "agent");
            asm volatile("s_waitcnt vmcnt(0)" ::: "memory");
            const unsigned og = xb_add(&bar[XB_TOP], 1u);
            const unsigned tg = og / nx;
            if (og + 1u == (tg + 1u) * nx) xb_add(&bar[XB_TOPGEN], 1u);
            else XB_SPIN(xb_ld(&bar[XB_TOPGEN]) == tg, bar);
            __builtin_amdgcn_fence(__ATOMIC_ACQUIRE, "agent");
            xb_add(&bar[XB_XGEN(b.x)], 1u);
            asm volatile("s_waitcnt vmcnt(0)" ::: "memory");
        } else {
            XB_SPIN(xb_ld(&bar[XB_XGEN(b.x)]) == gen, bar);
            __builtin_amdgcn_fence(__ATOMIC_ACQUIRE, "agent");
            asm volatile("s_waitcnt vmcnt(0)" ::: "memory");
        }
    }
    __syncthreads();
}

__device__ __forceinline__ int phase_class(int ph) {
    if (ph < 3) return ph;
    int q = ph - 3, l;
    if (q < 12) l = 0; else if (q < 22) { l = 1; q -= 12; } else if (q < 34) { l = 2; q -= 22; } else { l = 3; q -= 34; }
    const bool even = (l & 1) == 0; const int nm = even ? 5 : 3;
    if (q == 0) return 3; if (q == 1) return 4; if (q == 2) return 5;
    if (q < 3 + nm) return even ? 6 + (q - 3) : 11 + (q - 3);
    const int r = q - 3 - nm;
    return r == 0 ? 5 : (r == 1 ? 3 : (r == 2 ? 4 : 5));
}
__global__ void __launch_bounds__(512, 2) mega_kernel(Params pbyval) {
    extern __shared__ __attribute__((aligned(16))) unsigned char smem[];
    LAS unsigned char* lds = (LAS unsigned char*)smem;
    cg::grid_group grid = cg::this_grid();
    unsigned long long ka = (unsigned long long)__builtin_amdgcn_kernarg_segment_ptr();
    asm volatile("" : "+s"(ka));
    const int ph_lo = ((KP)ka)->ph_lo, ph_hi = ((KP)ka)->ph_hi;
    volatile LAS unsigned* xst = (volatile LAS unsigned*)(lds + 131072);
    if (threadIdx.x == 0) { xst[0] = 0u; xst[1] = 0u; }
    __syncthreads();
    const XcdBarrier xb = xcd_barrier_post((unsigned*)(((KP)ka)->ws + OFF_BAR), xst);
    for (int ph = ph_lo; ph < ph_hi; ++ph) {
#if REPEAT_MASK
        int reps = ((REPEAT_MASK >> phase_class(ph)) & 1) ? 2 : 1;
        for (int r = 0; r < reps; ++r) {
            asm volatile("" : "+s"(ka));
            if (r > 0) xcd_barrier(xb);
            if (!(r > 0 && (REPEAT_MASK >> 14) & 1)) run_phase((KP)ka, lds, ph);
        }
#else
        asm volatile("" : "+s"(ka));
        run_phase((KP)ka, lds, ph);
#endif
        if (ph + 1 < ph_hi) { if (ph_hi > 100000) grid.sync(); xcd_barrier(xb); }
    }
}

static void add_job(Params& p, int& nj, int& tiles, const float* src, bf16_t* dst, int K, int lds, int ncols, int nvalid, int sblk, int sstride, int soff, int dblk, int dstride, int doff) {
    TJob& J = p.jobs[nj++]; J.src = src; J.dst = dst; J.K = K; J.lds = lds; J.ncols = ncols; J.nvalid = nvalid; J.sblk = sblk; J.sstride = sstride; J.soff = soff;
    J.dblk = dblk; J.dstride = dstride; J.doff = doff; J.tile0 = tiles; J.pad = 0; tiles += (K / 64) * (ncols / 64);
}

extern "C" void kernel_launch(void* const* d_in, const int* in_sizes, int n_in, void* d_out, int out_size, void* d_ws, size_t ws_size, hipStream_t stream) {
    static int grid = 0;
    if (grid == 0) {
        if (n_in != 24 || ws_size < WS_NEED) { fprintf(stderr, "kernel_launch: need 24 inputs and %zu bytes of workspace; got %d, %zu\n", (size_t)WS_NEED, n_in, ws_size); grid = -1; return; }
        int dev = 0, cus = 0, per_cu = 0;
        hipGetDevice(&dev); hipDeviceGetAttribute(&cus, hipDeviceAttributeMultiprocessorCount, dev);
        if (hipFuncSetAttribute((const void*)mega_kernel, hipFuncAttributeMaxDynamicSharedMemorySize, LDS_BYTES) != hipSuccess) { fprintf(stderr, "hipFuncSetAttribute failed\n"); grid = -1; return; }
        hipOccupancyMaxActiveBlocksPerMultiprocessor(&per_cu, (const void*)mega_kernel, 512, LDS_BYTES);
        if (per_cu < 1) { fprintf(stderr, "occupancy query says %d blocks per CU\n", per_cu); per_cu = 1; }
        (void)hipGetLastError();
        grid = cus * 1;
    }
    if (grid < 0) return;
    Params p; memset(&p, 0, sizeof(p));
    const float** ip = (const float**)&p.x_prompt;
    for (int i = 0; i < 24; ++i) ip[i] = (const float*)d_in[i];
    p.out = (float*)d_out; p.ws = (unsigned char*)d_ws;
    unsigned char* ws = (unsigned char*)d_ws;
    int nj = 0, tiles = 0; const int BIG = 1 << 30;
    for (int lf = 0; lf < 8; ++lf) {
        add_job(p, nj, tiles, p.ffn_w_gate + (size_t)lf * 1024 * 2816, (bf16_t*)(ws + OFF_W1T) + (size_t)lf * 5632 * 1024, 1024, 2816, 2816, 2816, BIG, 0, 0, 128, 256, 0);
        add_job(p, nj, tiles, p.ffn_w_up + (size_t)lf * 1024 * 2816, (bf16_t*)(ws + OFF_W1T) + (size_t)lf * 5632 * 1024, 1024, 2816, 2816, 2816, BIG, 0, 0, 128, 256, 128);
        add_job(p, nj, tiles, p.ffn_w_down + (size_t)lf * 2816 * 1024, (bf16_t*)(ws + OFF_W2T) + (size_t)lf * 1024 * 2816, 2816, 1024, 1024, 1024, BIG, 0, 0, BIG, 0, 0);
    }
    for (int i = 0; i < 2; ++i) {
        add_job(p, nj, tiles, p.ab_w_in + (size_t)i * 1024 * 1440, (bf16_t*)(ws + OFF_WINT) + (size_t)i * 1536 * 1024, 1024, 1440, 1536, 1440, BIG, 0, 0, BIG, 0, 0);
        add_job(p, nj, tiles, p.ab_w_out + (size_t)i * 1024 * 1024, (bf16_t*)(ws + OFF_WOUTT) + (size_t)i * 1024 * 1024, 1024, 1024, 1024, 1024, BIG, 0, 0, BIG, 0, 0);
        add_job(p, nj, tiles, p.b_w_uq + (size_t)i * 384 * 768, (bf16_t*)(ws + OFF_WUQT) + (size_t)i * 768 * 384, 384, 768, 768, 768, BIG, 0, 0, BIG, 0, 0);
        add_job(p, nj, tiles, p.b_w_ukv + (size_t)i * 256 * 1024, (bf16_t*)(ws + OFF_WUKT) + (size_t)i * 512 * 256, 256, 1024, 512, 512, 64, 128, 0, BIG, 0, 0);
        add_job(p, nj, tiles, p.b_w_ukv + (size_t)i * 256 * 1024, (bf16_t*)(ws + OFF_WUVT) + (size_t)i * 512 * 256, 256, 1024, 512, 512, 64, 128, 64, BIG, 0, 0);
        add_job(p, nj, tiles, p.f_w_out + (size_t)i * 1024 * 1024, (bf16_t*)(ws + OFF_WFOUTT) + (size_t)i * 1024 * 1024, 1024, 1024, 1024, 1024, BIG, 0, 0, BIG, 0, 0);
    }
    p.ntiles_total = tiles;
    if (p.jobs[24].tile0 != 8 * LF_TILES) { fprintf(stderr, "kernel_launch: job table does not match LF_TILES\n"); return; }
#if SINGLE_LAUNCH
    (void)hipMemsetAsync(ws + OFF_BAR, 0, 16384, stream);
    p.ph_lo = 0; p.ph_hi = NPH;
    void* args[] = {&p};
    hipError_t e = hipLaunchCooperativeKernel((const void*)mega_kernel, dim3(grid), dim3(512), args, LDS_BYTES, stream);
    if (e != hipSuccess) fprintf(stderr, "cooperative launch failed: %s (grid %d)\n", hipGetErrorString(e), grid);
#else
    for (int ph = 0; ph < NPH; ++ph) { p.ph_lo = ph; p.ph_hi = ph + 1; hipLaunchKernelGGL(mega_kernel, dim3(grid), dim3(512), LDS_BYTES, stream, p); }
#endif
}
```
